# Optimizing an MI355X kernel written in HIP

```python
import math, functools
import jax, jax.numpy as jnp
from jax import lax
import numpy as np

D_MODEL = 1024
BATCH = 8
SEQ = 4096
DEPTH = 1
DEC_BATCH = 128
DEC_SEQ = 4
PAST_LEN = 16384
PAGE_SIZE = 128

A_HEADS = 8
A_KDIM = 128
A_VDIM = D_MODEL // A_HEADS
A_KW = A_HEADS * A_KDIM
A_VW = A_HEADS * A_VDIM
A_CHUNK = 64
B_QHEADS = 16
B_KVHEADS = 2
B_HDIM = 64
B_GROUP = B_QHEADS // B_KVHEADS
B_QW = B_QHEADS * B_HDIM
B_KVW = B_KVHEADS * B_HDIM
WINDOW = 128
EPS = 1e-6
NEG = -1e30
SPLITS = (A_KW, A_KW, A_VW, A_VW, B_QW, B_KVW, B_KVW, B_QW, D_MODEL, D_MODEL)
IN_COLS = A_KW + A_KW + A_VW + A_VW + B_QW + B_KVW + B_KVW + B_QW + D_MODEL + D_MODEL

kernel_name = "hgrn2_swa_sink_gated_hybrid_step"


def rmsnorm(x, g):
    xf = x.astype(jnp.float32)
    y = xf * lax.rsqrt(jnp.mean(xf * xf, axis=-1, keepdims=True) + EPS)
    return (y * g.astype(jnp.float32)).astype(x.dtype)


def alibi_slopes(n):
    return 2.0 ** (-8.0 * jnp.arange(1, n + 1, dtype=jnp.float32) / n)


def in_projection(xn, w_in):
    h = jnp.einsum('btd,dc->btc', xn, w_in)
    offs = [int(o) for o in np.cumsum(SPLITS)[:-1]]
    return jnp.split(h, offs, axis=-1)


def hgrn2_features(qa, fa, ia, lb):
    B, T, _ = qa.shape
    q = jax.nn.silu(qa.astype(jnp.float32))
    sig = jax.nn.sigmoid(fa.astype(jnp.float32))
    lbf = lb.astype(jnp.float32)
    f = lbf + (1.0 - lbf) * sig
    k = (1.0 - lbf) * (1.0 - sig)
    logf = jnp.log(f)
    shp = (B, T, A_HEADS, A_KDIM)
    v = ia.astype(jnp.float32).reshape(B, T, A_HEADS, A_VDIM)
    return q.reshape(shp), k.reshape(shp), v, logf.reshape(shp)


def hgrn2_chunk(S, q, k, v, logf):
    C = q.shape[1]
    b = jnp.cumsum(logf, axis=1)
    causal = jnp.tril(jnp.ones((C, C), dtype=bool))[None, :, :, None, None]
    diff = b[:, :, None] - b[:, None, :]
    decay = jnp.where(causal, jnp.exp(jnp.where(causal, diff, 0.0)), 0.0)
    att = jnp.einsum('bthk,bshk,btshk->bhts', q, k, decay)
    o = jnp.einsum('bhts,bshv->bthv', att, v) + jnp.einsum('bthk,bhkv->bthv', q * jnp.exp(b), S)
    b_last = b[:, -1]
    k_dec = k * jnp.exp(b_last[:, None] - b)
    S_new = jnp.exp(b_last)[..., None] * S + jnp.einsum('bshk,bshv->bhkv', k_dec, v)
    return S_new, o


def hgrn2_prompt(q, k, v, logf):
    B, T = q.shape[:2]
    n_chunks = T // A_CHUNK

    def to_chunks(a):
        return a.reshape((B, n_chunks, A_CHUNK) + a.shape[2:]).swapaxes(0, 1)

    S0 = jnp.zeros((B, A_HEADS, A_KDIM, A_VDIM), jnp.float32)
    S_fin, o = lax.scan(lambda S, inp: hgrn2_chunk(S, *inp), S0,
                        (to_chunks(q), to_chunks(k), to_chunks(v), to_chunks(logf)))
    o = o.swapaxes(0, 1).reshape(B, T, A_HEADS, A_VDIM)
    return o, S_fin


def hgrn2_sample(q, k, v, logf, S):
    S_new, o = hgrn2_chunk(S.astype(jnp.float32), q, k, v, logf)
    return o, S_new


def sink_softmax(s, sinks):
    sk = jnp.broadcast_to(sinks.astype(jnp.float32).reshape(B_KVHEADS, B_GROUP, 1, 1), s.shape[:-1] + (1,))
    return jax.nn.softmax(jnp.concatenate([s, sk], axis=-1), axis=-1)[..., :-1]


def swa_prompt(q, k, v, sinks):
    B, T, _ = q.shape
    nb = T // WINDOW
    scale = 1.0 / math.sqrt(B_HDIM)
    qb = q.reshape(B, nb, WINDOW, B_KVHEADS, B_GROUP, B_HDIM)
    kb = k.reshape(B, nb, WINDOW, B_KVHEADS, B_HDIM)
    vb = v.reshape(B, nb, WINDOW, B_KVHEADS, B_HDIM)

    def prev(a):
        return jnp.concatenate([jnp.zeros_like(a[:, :1]), a[:, :-1]], axis=1)

    kk = jnp.concatenate([prev(kb), kb], axis=2)
    vv = jnp.concatenate([prev(vb), vb], axis=2)
    qi = jnp.arange(WINDOW)[:, None]
    kj = jnp.arange(2 * WINDOW)[None, :] - WINDOW
    dist = (qi - kj).astype(jnp.float32)
    band = ((qi - kj) >= 0) & ((qi - kj) < WINDOW)
    valid = band[None] & ((jnp.arange(nb)[:, None, None] > 0) | (kj >= 0)[None])
    s = jnp.einsum('bnqhgd,bnshd->bnhgqs', qb, kk).astype(jnp.float32) * scale
    s = s - alibi_slopes(B_QHEADS).reshape(B_KVHEADS, B_GROUP, 1, 1) * dist
    s = jnp.where(valid[None, :, None, None], s, NEG)
    p = sink_softmax(s, sinks)
    o = jnp.einsum('bnhgqs,bnshd->bnqhgd', p, vv.astype(jnp.float32)).reshape(B, T, B_QW)
    L = min(WINDOW, T)
    ck = k[:, T - L:].reshape(B, L, B_KVHEADS, B_HDIM)
    cv = v[:, T - L:].reshape(B, L, B_KVHEADS, B_HDIM)
    return o, ck, cv


def swa_sample(q, k, v, sinks, ck, cv):
    DB, T, _ = q.shape
    L = ck.shape[1]
    scale = 1.0 / math.sqrt(B_HDIM)
    qr = q.reshape(DB, T, B_KVHEADS, B_GROUP, B_HDIM)
    kk = jnp.concatenate([ck.astype(k.dtype), k.reshape(DB, T, B_KVHEADS, B_HDIM)], axis=1)
    vv = jnp.concatenate([cv.astype(v.dtype), v.reshape(DB, T, B_KVHEADS, B_HDIM)], axis=1)
    qpos = jnp.arange(T)[:, None]
    kpos = jnp.concatenate([jnp.arange(L) - L, jnp.arange(T)])[None, :]
    d = qpos - kpos
    valid = (d >= 0) & (d < WINDOW)
    s = jnp.einsum('bqhgd,bshd->bhgqs', qr, kk).astype(jnp.float32) * scale
    s = s - alibi_slopes(B_QHEADS).reshape(B_KVHEADS, B_GROUP, 1, 1) * d.astype(jnp.float32)
    s = jnp.where(valid, s, NEG)
    p = sink_softmax(s, sinks)
    o = jnp.einsum('bhgqs,bshd->bqhgd', p, vv.astype(jnp.float32)).reshape(DB, T, B_QW)
    return o, kk[:, -L:], vv[:, -L:]


def decoder_layer(x, hgrn_fn, swa_fn, norm_in, w_in, lb, a_gnorm, b_sinks, w_pa, w_pb, w_out):
    xn = rmsnorm(x, norm_in)
    qa, fa, ia, za, qb, kb, vb, zb, ga, gb = in_projection(xn, w_in)
    q, k, v, logf = hgrn2_features(qa, fa, ia, lb)
    oa, S_new = hgrn_fn(q, k, v, logf)
    oa = oa * lax.rsqrt(jnp.mean(oa * oa, axis=-1, keepdims=True) + EPS) * a_gnorm.astype(jnp.float32)
    B, T = x.shape[:2]
    ha = oa.reshape(B, T, A_VW) * jax.nn.silu(za.astype(jnp.float32))
    ob, ck, cv = swa_fn(qb, kb, vb, b_sinks)
    hb = ob * jax.nn.silu(zb.astype(jnp.float32))
    pa = jnp.einsum('btc,cd->btd', ha.astype(x.dtype), w_pa)
    pb = jnp.einsum('btc,cd->btd', hb.astype(x.dtype), w_pb)
    merged = jax.nn.sigmoid(ga.astype(jnp.float32)) * pa + jax.nn.sigmoid(gb.astype(jnp.float32)) * pb
    y = x + jnp.einsum('btd,de->bte', merged.astype(x.dtype), w_out)
    return y.astype(x.dtype), S_new, ck, cv


def setup_inputs(seed: int = 0) -> dict:
    key = jax.random.key(seed)
    ks = jax.random.split(key, 16)
    L = min(WINDOW, PAST_LEN)
    f32 = jnp.float32
    return {
        "x_prompt": jax.random.normal(ks[0], (BATCH, SEQ, D_MODEL), f32),
        "x_sample": jax.random.normal(ks[1], (DEC_BATCH, DEC_SEQ, D_MODEL), f32),
        "state_hgrn": 0.5 * jax.random.normal(ks[2], (DEPTH, DEC_BATCH, A_HEADS, A_KDIM, A_VDIM), f32),
        "cache_k": jax.random.normal(ks[3], (DEPTH, DEC_BATCH, L, B_KVHEADS, B_HDIM), f32),
        "cache_v": jax.random.normal(ks[4], (DEPTH, DEC_BATCH, L, B_KVHEADS, B_HDIM), f32),
        "norm_in": 1.0 + 0.02 * jax.random.normal(ks[5], (DEPTH, D_MODEL), f32),
        "w_in": jax.random.normal(ks[6], (DEPTH, D_MODEL, IN_COLS), f32) * D_MODEL ** -0.5,
        "lb_logits": 0.5 * jax.random.normal(ks[7], (DEPTH + 1, A_KW), f32),
        "a_gnorm": 1.0 + 0.02 * jax.random.normal(ks[8], (DEPTH, A_VDIM), f32),
        "b_sinks": 0.5 * jax.random.normal(ks[9], (DEPTH, B_QHEADS), f32),
        "w_pa": jax.random.normal(ks[10], (DEPTH, A_VW, D_MODEL), f32) * A_VW ** -0.5,
        "w_pb": jax.random.normal(ks[11], (DEPTH, B_QW, D_MODEL), f32) * B_QW ** -0.5,
        "w_out": jax.random.normal(ks[12], (DEPTH, D_MODEL, D_MODEL), f32) * D_MODEL ** -0.5,
        "norm_final": 1.0 + 0.02 * jax.random.normal(ks[13], (D_MODEL,), f32),
    }


def reference(x_prompt, x_sample, state_hgrn, cache_k, cache_v, norm_in, w_in, lb_logits, a_gnorm,
              b_sinks, w_pa, w_pb, w_out, norm_final):
    lbs = jnp.cumsum(jax.nn.softmax(lb_logits.astype(jnp.float32), axis=0), axis=0)
    hp, hs = x_prompt, x_sample
    sp, kp, vp, ss, ksm, vsm = [], [], [], [], [], []
    for l in range(DEPTH):
        w = (norm_in[l], w_in[l], lbs[l], a_gnorm[l], b_sinks[l], w_pa[l], w_pb[l], w_out[l])
        hp, s_p, k_p, v_p = decoder_layer(hp, hgrn2_prompt, swa_prompt, *w)
        hs, s_s, k_s, v_s = decoder_layer(
            hs, functools.partial(hgrn2_sample, S=state_hgrn[l]),
            functools.partial(swa_sample, ck=cache_k[l], cv=cache_v[l]), *w)
        sp.append(s_p.astype(state_hgrn.dtype)); kp.append(k_p.astype(cache_k.dtype)); vp.append(v_p.astype(cache_v.dtype))
        ss.append(s_s.astype(state_hgrn.dtype)); ksm.append(k_s.astype(cache_k.dtype)); vsm.append(v_s.astype(cache_v.dtype))
    y_prompt = rmsnorm(hp, norm_final)
    y_sample = rmsnorm(hs, norm_final)
    state_hgrn_prompt = jnp.stack(sp)
    cache_k_prompt = jnp.stack(kp)
    cache_v_prompt = jnp.stack(vp)
    state_hgrn_sample = jnp.stack(ss)
    cache_k_sample = jnp.stack(ksm)
    cache_v_sample = jnp.stack(vsm)
    return (y_prompt, y_sample, state_hgrn_prompt, cache_k_prompt, cache_v_prompt,
            state_hgrn_sample, cache_k_sample, cache_v_sample)
```

```cpp
#include <hip/hip_runtime.h>
#include <cstdio>
#include <cstdint>

#ifndef MK_N_LAUNCHES
#define MK_N_LAUNCHES 8
#endif

constexpr int D = 1024, MP = 32768, MS = 512, M = MP + MS, SEQ = 4096, NIN = 8448;
constexpr int LDH = 6400;
constexpr int HC_QA = 0, HC_G2 = 1024, HC_VA = 2048, HC_ZA = 3072, HC_QB = 4096, HC_KB = 5120, HC_VB = 5248, HC_ZB = 5376;
constexpr int HC_HA = HC_VA, HC_HB = HC_QB, HC_GA = 0, HC_GB = 1024, HC_MG = HC_ZA;
constexpr int NMIX = 6400;
constexpr float EPS = 1e-6f, LOG2E = 1.4426950408889634f, C2 = 0.125f * 1.4426950408889634f;
constexpr size_t O_Y = 0, O_SP = 34078720, O_CKP = 35127296, O_CVP = 35258368, O_SS = 35389440, O_CKS = 52166656, O_CVS = 54263808, O_END = 56360960;
constexpr size_t MiB = 1u << 20;
constexpr size_t WS_CTL = 0, CTL_ZERO_BYTES = 1 * MiB;
constexpr size_t WS_LB = 1 * MiB;
constexpr size_t WS_CKP = 1 * MiB + 65536, WS_CVP = WS_CKP + 524288, WS_CKSN = WS_CVP + 524288, WS_CVSN = WS_CKSN + 262144;
constexpr size_t WS_WIN = 3 * MiB;
constexpr size_t WS_WPA = 20 * MiB, WS_WPB = 22 * MiB, WS_WOUT = 24 * MiB;
constexpr size_t WS_XN = 26 * MiB;
constexpr size_t WS_SSQ = 26 * MiB;
constexpr size_t WS_H = 91 * MiB;
constexpr size_t WS_END = WS_H + (size_t)M * LDH * 2;
static_assert(WS_CVSN + 262144 <= WS_WIN && WS_XN + (size_t)M * D * 2 <= WS_H && WS_END <= 512 * MiB, "ws map");

namespace pg8 {
#define PG8_LAS __attribute__((address_space(3)))
typedef unsigned short bf16_t;
typedef short bf16x8 __attribute__((ext_vector_type(8)));
typedef float f32x4 __attribute__((ext_vector_type(4)));
typedef unsigned u32x4 __attribute__((ext_vector_type(4)));
constexpr int BM = 256, BK = 64, HALF = 128, HTB = HALF * BK * 2, STAGE_BYTES = 8 * HTB, NXCD = 8, WGM = 8;

__host__ __device__ __forceinline__ int lds_byte(int r, int c) { const int st = (r >> 4) * 2 + (c >> 5), rr = r & 15, cc = c & 31, ob = rr * 64 + cc * 2; return st * 1024 + (ob ^ (((ob >> 9) & 1) << 5)); }
__host__ __device__ __forceinline__ void stage_rc(int b, int& R, int& C) { const int st = b / 1024, sb = b % 1024, swz = sb ^ (((sb >> 9) & 1) << 5); R = (st >> 1) * 16 + swz / 64; C = (st & 1) * 32 + (swz % 64) / 2; }
__host__ __device__ __forceinline__ int perm32(int rho) { const int n = rho >> 4, i = rho & 15; return 8 * (i >> 2) + 4 * n + (i & 3); }

struct Unit { int pm, pn, sub; };
struct Gemm { const bf16_t *A0, *A1, *B0, *B1; int lda, ldb, K; };

struct StaticOrder {
    int nM, nN, nwg, G, c, dbl;
    __host__ __device__ void init(int M_, int N_, int G_, int c_, int dbl_) { nM = M_ / BM; nN = N_ / BM; nwg = nM * nN; G = G_; c = c_; dbl = dbl_; }
    __host__ __device__ bool next(int i, Unit& u) const {
        const int it = dbl ? (i >> 1) : i; u.sub = dbl ? (i & 1) : 0;
        const long L = (long)it * G + c; if (L >= nwg) return false;
        int wgid = (int)L; { const int q = nwg / NXCD, r = nwg % NXCD, xcd = wgid % NXCD, off = wgid / NXCD; wgid = (xcd < r ? xcd * (q + 1) : r * (q + 1) + (xcd - r) * q) + off; }
        const int nig = WGM * nN, gid = wgid / nig, fm = gid * WGM, gsz = (nM - fm) < WGM ? (nM - fm) : WGM;
        u.pm = fm + ((wgid % nig) % gsz); u.pn = (wgid % nig) / gsz; return true;
    }
};

typedef float f32x2_t __attribute__((ext_vector_type(2))); typedef __bf16 bf16x2_t __attribute__((ext_vector_type(2)));
__device__ __forceinline__ unsigned cvt_pk_bf16(float lo, float hi) { f32x2_t v = {lo, hi}; bf16x2_t b = __builtin_convertvector(v, bf16x2_t); return __builtin_bit_cast(unsigned, b); }
__device__ __forceinline__ float bf_lo(unsigned w) { return __uint_as_float(w << 16); }
__device__ __forceinline__ float bf_hi(unsigned w) { return __uint_as_float(w & 0xffff0000u); }

typedef f32x4 Acc[2][2][4][2];

template <class Epi, class Sched>
__device__ __forceinline__ void gemm_phase(PG8_LAS unsigned char* lds, const Gemm g, const Sched& S, const Epi& E) {
    const int tid = threadIdx.x, wid = __builtin_amdgcn_readfirstlane(tid >> 6), lane = tid & 63, wr = wid >> 2, wc = wid & 3, fr = lane & 15, fq = lane >> 4;
    const int K = g.K, nt = K / BK;
    unsigned voffA[2], voffB[2];
#pragma unroll
    for (int i = 0; i < 2; ++i) { int R, C; stage_rc(tid * 16 + i * 8192, R, C); const int Rb = Epi::PERM ? ((R & ~31) + perm32(R & 31)) : R;
        voffA[i] = (unsigned)(R * g.lda + C) * 2u; voffB[i] = (unsigned)(Rb * g.ldb + C) * 2u; }
    const size_t kstep = (size_t)(BK * 2);
    const size_t hstepA = (size_t)HALF * g.lda * 2, hstepB = (size_t)HALF * g.ldb * 2;
    const size_t tstepA = 2 * hstepA, tstepB = 2 * hstepB;
    const unsigned ldsw = (unsigned)wid * 1024u;
    const int aoff = lds_byte(wr * 64 + fr, fq * 8), boff = lds_byte(wc * 32 + fr, fq * 8);
#define PG8_SA(b, h) (((b) * 2 + (h)) * HTB)
#define PG8_SB(b, h) ((4 + (b) * 2 + (h)) * HTB)
#define PG8_STAGE(bufoff, gbase, voff) do { _Pragma("unroll") for (int _i = 0; _i < 2; ++_i) \
        __builtin_amdgcn_global_load_lds((const unsigned*)((const char*)(gbase) + (voff)[_i]), (PG8_LAS unsigned*)(lds + (bufoff) + ldsw + _i * 8192), 16, 0, 0); } while (0)
#define PG8_LDA(dst, b, h) do { _Pragma("unroll") for (int m = 0; m < 4; ++m) _Pragma("unroll") for (int k = 0; k < 2; ++k) dst[m][k] = *(const PG8_LAS bf16x8*)(lds + PG8_SA(b, h) + aoff + m * 2048 + k * 1024); } while (0)
#define PG8_LDB(dst, b, h) do { _Pragma("unroll") for (int n = 0; n < 2; ++n) _Pragma("unroll") for (int k = 0; k < 2; ++k) dst[n][k] = *(const PG8_LAS bf16x8*)(lds + PG8_SB(b, h) + boff + n * 2048 + k * 1024); } while (0)
#define PG8_MMA(ai, bj, At, Bt) do { __builtin_amdgcn_s_setprio(1); _Pragma("unroll") for (int m = 0; m < 4; ++m) _Pragma("unroll") for (int n = 0; n < 2; ++n) _Pragma("unroll") for (int k = 0; k < 2; ++k) \
        acc[ai][bj][m][n] = __builtin_amdgcn_mfma_f32_16x16x32_bf16(Bt[n][k], At[m][k], acc[ai][bj][m][n], 0, 0, 0); __builtin_amdgcn_s_setprio(0); } while (0)
#define PG8_WAIT_V(n) asm volatile("s_waitcnt vmcnt(" #n ")" ::: "memory")
#define PG8_WAIT_L(n) asm volatile("s_waitcnt lgkmcnt(" #n ")" ::: "memory")
#define PG8_BAR __builtin_amdgcn_s_barrier()
#define PG8_SCHED __builtin_amdgcn_sched_barrier(0)
    Unit cur, nxt; int ui = 0;
    if (!S.next(0, cur)) return;
    Acc acc;
#pragma unroll
    for (int a = 0; a < 2; ++a)
#pragma unroll
        for (int b = 0; b < 2; ++b)
#pragma unroll
            for (int m = 0; m < 4; ++m)
#pragma unroll
                for (int n = 0; n < 2; ++n) acc[a][b][m][n] = (f32x4){0.f, 0.f, 0.f, 0.f};
    bf16x8 At[4][2], B0[2][2], B1[2][2];
    const char* cA = (const char*)(cur.sub ? g.A1 : g.A0) + (size_t)cur.pm * tstepA; const char* cB = (const char*)(cur.sub ? g.B1 : g.B0) + (size_t)cur.pn * tstepB;
    PG8_STAGE(PG8_SB(0, 0), cB, voffB); PG8_STAGE(PG8_SB(0, 1), cB + hstepB, voffB); PG8_STAGE(PG8_SA(0, 0), cA, voffA); PG8_STAGE(PG8_SA(0, 1), cA + hstepA, voffA);
    if (wr == 1) PG8_BAR;
    PG8_WAIT_V(2); PG8_BAR;
    PG8_STAGE(PG8_SB(1, 0), cB + kstep, voffB); PG8_STAGE(PG8_SA(1, 0), cA + kstep, voffA); PG8_STAGE(PG8_SB(1, 1), cB + hstepB + kstep, voffB);
    PG8_WAIT_V(6); PG8_BAR;
    for (;;) {
        const bool has_next = S.next(ui + 1, nxt);
        const char* nA = has_next ? (const char*)(nxt.sub ? g.A1 : g.A0) + (size_t)nxt.pm * tstepA : cA; const char* nB = has_next ? (const char*)(nxt.sub ? g.B1 : g.B0) + (size_t)nxt.pn * tstepB : cB;
        for (int t = 0; t < nt; t += 2) {
            const bool last = (t == nt - 2);
            const char* a1 = cA + (size_t)(t + 1) * kstep;
            const char* a2 = last ? nA : cA + (size_t)(t + 2) * kstep; const char* b2 = last ? nB : cB + (size_t)(t + 2) * kstep;
            const char* a3 = a2 + kstep; const char* b3 = b2 + kstep;
            PG8_LDB(B0, 0, 0); PG8_LDB(B1, 0, 1); PG8_SCHED; PG8_LDA(At, 0, 0); PG8_STAGE(PG8_SA(1, 1), a1 + hstepA, voffA);
            PG8_WAIT_V(8); PG8_WAIT_L(0); PG8_BAR; PG8_MMA(0, 0, At, B0); PG8_MMA(0, 1, At, B1); PG8_BAR; PG8_SCHED;
            PG8_LDA(At, 0, 1); PG8_STAGE(PG8_SB(0, 0), b2, voffB); PG8_STAGE(PG8_SB(0, 1), b2 + hstepB, voffB); PG8_STAGE(PG8_SA(0, 0), a2, voffA);
            PG8_WAIT_V(8); PG8_WAIT_L(0); PG8_BAR; PG8_MMA(1, 0, At, B0); PG8_MMA(1, 1, At, B1); PG8_BAR; PG8_SCHED;
            PG8_LDB(B0, 1, 0); PG8_LDB(B1, 1, 1); PG8_SCHED; PG8_LDA(At, 1, 0); PG8_STAGE(PG8_SA(0, 1), a2 + hstepA, voffA);
            PG8_WAIT_V(8); PG8_WAIT_L(0); PG8_BAR; PG8_MMA(0, 0, At, B0); PG8_MMA(0, 1, At, B1); PG8_BAR; PG8_SCHED;
            PG8_LDA(At, 1, 1); PG8_STAGE(PG8_SB(1, 0), b3, voffB); PG8_STAGE(PG8_SB(1, 1), b3 + hstepB, voffB); PG8_STAGE(PG8_SA(1, 0), a3, voffA);
            PG8_WAIT_V(8); PG8_WAIT_L(0); PG8_BAR; PG8_MMA(1, 0, At, B0); PG8_MMA(1, 1, At, B1); PG8_BAR; PG8_SCHED;
        }
        if (wr == 0) PG8_BAR;
        const bool keep = E(acc, cur, wr, wc, fr, fq);
        if (!has_next) break;
        if (!keep) {
#pragma unroll
        for (int a = 0; a < 2; ++a)
#pragma unroll
            for (int b = 0; b < 2; ++b)
#pragma unroll
                for (int m = 0; m < 4; ++m)
#pragma unroll
                    for (int n = 0; n < 2; ++n) acc[a][b][m][n] = (f32x4){0.f, 0.f, 0.f, 0.f};
        }
        cur = nxt; cA = nA; cB = nB; ++ui;
        if (wr == 1) PG8_BAR;
    }
    PG8_WAIT_V(0);
    PG8_BAR;
#undef PG8_SA
#undef PG8_SB
#undef PG8_STAGE
#undef PG8_LDA
#undef PG8_LDB
#undef PG8_MMA
#undef PG8_WAIT_V
#undef PG8_WAIT_L
#undef PG8_BAR
#undef PG8_SCHED
}

__device__ __forceinline__ float sigmoidf_(float x) { return __builtin_amdgcn_rcpf(1.0f + __builtin_amdgcn_exp2f(-x * LOG2E)); }
__device__ __forceinline__ float siluf_(float x) { return x * sigmoidf_(x); }
__device__ __forceinline__ unsigned cvt_pk_f16(float lo, float hi) { typedef _Float16 h2 __attribute__((ext_vector_type(2))); h2 v; v.x = (_Float16)lo; v.y = (_Float16)hi; return __builtin_bit_cast(unsigned, v); }

struct EpiIn {
    static constexpr bool PERM = true;
    bf16_t* H; const float* lb; float *ckp, *cvp, *cksn, *cvsn; int gate;
    template <int MODE> __device__ __forceinline__ void run(Acc& acc, const Unit& u, int wr, int wc, int fr, int fq) const {
        const int row0 = u.pm * BM + wr * 64 + fr, cb = wc * 32 + 8 * fq;
        bf16_t* base; int ld;
        base = H + u.pn * 256 + cb; ld = LDH;
        float lbv[2][8];
        if (MODE == 2) {
#pragma unroll
            for (int bj = 0; bj < 2; ++bj) { const f32x4 a = *(const f32x4*)(lb + (u.pn - 4) * 256 + bj * HALF + cb), b = *(const f32x4*)(lb + (u.pn - 4) * 256 + bj * HALF + cb + 4);
                lbv[bj][0] = a[0]; lbv[bj][1] = a[1]; lbv[bj][2] = a[2]; lbv[bj][3] = a[3]; lbv[bj][4] = b[0]; lbv[bj][5] = b[1]; lbv[bj][6] = b[2]; lbv[bj][7] = b[3]; }
        }
#pragma unroll
        for (int ai = 0; ai < 2; ++ai)
#pragma unroll
            for (int m = 0; m < 4; ++m) { const int row = row0 + ai * HALF + m * 16; bf16_t* rowp = base + (size_t)row * ld;
#pragma unroll
                for (int bj = 0; bj < 2; ++bj) { float v[8];
#pragma unroll
                    for (int j = 0; j < 4; ++j) { v[j] = acc[ai][bj][m][0][j]; v[4 + j] = acc[ai][bj][m][1][j]; }
                    if (MODE == 5) {
                        float* dst = nullptr;
                        if (row < MP) { const int t = row & (SEQ - 1); if (t >= SEQ - 128) dst = (bj ? cvp : ckp) + ((size_t)((row >> 12) * 128 + (t - (SEQ - 128))) * 128 + cb); }
                        else { const int ms = row - MP; dst = (bj ? cvsn : cksn) + ((size_t)ms * 128 + cb); }
                        if (dst) { *(f32x4*)dst = acc[ai][bj][m][0]; *(f32x4*)(dst + 4) = acc[ai][bj][m][1]; }
                    }
                    u32x4 w;
                    if (MODE == 2) {
#pragma unroll
                        for (int j = 0; j < 8; ++j) { const float l = lbv[bj][j]; v[j] = __builtin_amdgcn_logf(l + (1.0f - l) * sigmoidf_(v[j])); }
                        w.x = cvt_pk_f16(v[0], v[1]); w.y = cvt_pk_f16(v[2], v[3]); w.z = cvt_pk_f16(v[4], v[5]); w.w = cvt_pk_f16(v[6], v[7]);
                    } else {
#pragma unroll
                        for (int j = 0; j < 8; ++j) { if (MODE == 1) v[j] = siluf_(v[j]); if (MODE == 3) v[j] *= C2; if (MODE == 4) v[j] = sigmoidf_(v[j]); }
                        w.x = cvt_pk_bf16(v[0], v[1]); w.y = cvt_pk_bf16(v[2], v[3]); w.z = cvt_pk_bf16(v[4], v[5]); w.w = cvt_pk_bf16(v[6], v[7]);
                    }
                    *(u32x4*)(rowp + bj * HALF) = w; } }
    }
    __device__ __forceinline__ bool operator()(Acc& acc, const Unit& u, int wr, int wc, int fr, int fq) const {
        const int pn = u.pn;
        if (gate) { run<4>(acc, u, wr, wc, fr, fq); return false; }
        if (pn < 4) run<1>(acc, u, wr, wc, fr, fq);
        else if (pn < 8) run<2>(acc, u, wr, wc, fr, fq);
        else if (pn < 12) run<0>(acc, u, wr, wc, fr, fq);
        else if (pn < 16) run<1>(acc, u, wr, wc, fr, fq);
        else if (pn < 20) run<3>(acc, u, wr, wc, fr, fq);
        else if (pn == 20) run<5>(acc, u, wr, wc, fr, fq);
        else run<1>(acc, u, wr, wc, fr, fq);
        return false;
    }
};

struct EpiMerge {
    static constexpr bool PERM = true;
    const bf16_t* HG; bf16_t* MG;
    __device__ __forceinline__ bool operator()(Acc& acc, const Unit& u, int wr, int wc, int fr, int fq) const {
        const int row0 = u.pm * BM + wr * 64 + fr, col0 = u.pn * BM + wc * 32 + 8 * fq;
#pragma unroll
        for (int ai = 0; ai < 2; ++ai)
#pragma unroll
            for (int m = 0; m < 4; ++m) { const int row = row0 + ai * HALF + m * 16; const bf16_t* gp = HG + (size_t)row * LDH + col0;
#pragma unroll
                for (int bj = 0; bj < 2; ++bj) {
                    const u32x4 gb = *(const u32x4*)(gp + 1024 + bj * HALF);
                    float b[8] = {bf_lo(gb.x), bf_hi(gb.x), bf_lo(gb.y), bf_hi(gb.y), bf_lo(gb.z), bf_hi(gb.z), bf_lo(gb.w), bf_hi(gb.w)};
                    if (u.sub == 0) {
                        const u32x4 ga = *(const u32x4*)(gp + bj * HALF);
                        float a[8] = {bf_lo(ga.x), bf_hi(ga.x), bf_lo(ga.y), bf_hi(ga.y), bf_lo(ga.z), bf_hi(ga.z), bf_lo(ga.w), bf_hi(ga.w)};
#pragma unroll
                        for (int j = 0; j < 4; ++j) { acc[ai][bj][m][0][j] *= a[j] * __builtin_amdgcn_rcpf(b[j]); acc[ai][bj][m][1][j] *= a[4 + j] * __builtin_amdgcn_rcpf(b[4 + j]); }
                    } else {
                        float v[8];
#pragma unroll
                        for (int j = 0; j < 4; ++j) { v[j] = acc[ai][bj][m][0][j] * b[j]; v[4 + j] = acc[ai][bj][m][1][j] * b[4 + j]; }
                        u32x4 w; w.x = cvt_pk_bf16(v[0], v[1]); w.y = cvt_pk_bf16(v[2], v[3]); w.z = cvt_pk_bf16(v[4], v[5]); w.w = cvt_pk_bf16(v[6], v[7]);
                        *(u32x4*)(MG + (size_t)row * LDH + col0 + bj * HALF) = w;
                    } } }
        return u.sub == 0;
    }
};

struct EpiOut {
    static constexpr bool PERM = false;
    const float* xp; const float* xs; bf16_t* YT; float* SSQ;
    __device__ __forceinline__ bool operator()(Acc& acc, const Unit& u, int wr, int wc, int fr, int fq) const {
        const int row0 = u.pm * BM + wr * 64 + fr, col0 = u.pn * BM + wc * 32 + 4 * fq;
#pragma unroll
        for (int ai = 0; ai < 2; ++ai)
#pragma unroll
            for (int m = 0; m < 4; ++m) { const int row = row0 + ai * HALF + m * 16;
                const float* xr = (row < MP ? xp + (size_t)row * D : xs + (size_t)(row - MP) * D) + col0; float* yr = (float*)(YT + (size_t)row * LDH) + col0; float ss = 0.f;
#pragma unroll
                for (int bj = 0; bj < 2; ++bj)
#pragma unroll
                    for (int n = 0; n < 2; ++n) { const f32x4 y = *(const f32x4*)(xr + bj * HALF + n * 16) + acc[ai][bj][m][n]; *(f32x4*)(yr + bj * HALF + n * 16) = y;
                        ss += (y[0] * y[0] + y[1] * y[1]) + (y[2] * y[2] + y[3] * y[3]); }
                ss += __shfl_xor(ss, 16); ss += __shfl_xor(ss, 32);
                if (fq == 0) SSQ[(size_t)row * 16 + u.pn * 4 + wc] = ss; }
        return false;
    }
};
}

constexpr int NWAVES = 8;
constexpr int N_LAUNCHES = MK_N_LAUNCHES;
constexpr int NPHASE = 8;
constexpr int RING_BYTES = 131072, LDSCTL_OFF = RING_BYTES, MISC_OFF = LDSCTL_OFF + 320, LDS_BYTES = 147456;
constexpr int CW_BAR = 4096;

#define GAS __attribute__((address_space(1)))
#define LAS __attribute__((address_space(3)))
typedef unsigned short bf16;
typedef unsigned v4u __attribute__((ext_vector_type(4)));
typedef float f32x4 __attribute__((ext_vector_type(4)));
typedef GAS unsigned gu32;
#define RLX_AGENT __ATOMIC_RELAXED, __HIP_MEMORY_SCOPE_AGENT
#define LDS_WAIT() asm volatile("s_waitcnt lgkmcnt(0)" ::: "memory")
__device__ __forceinline__ unsigned f2bf(float f) { unsigned u = __builtin_bit_cast(unsigned, f); return (u + 0x7fffu + ((u >> 16) & 1u)) >> 16; }
__device__ __forceinline__ unsigned pk2(float lo, float hi) { return f2bf(lo) | (f2bf(hi) << 16); }
__device__ __forceinline__ float bf2f(bf16 h) { return __uint_as_float((unsigned)h << 16); }
__device__ __forceinline__ float h2f(bf16 h) { return (float)__builtin_bit_cast(_Float16, h); }

#define XB_TMO      128
#define XB_XCNT(j)  (256  + 64 * (j))
#define XB_XSUB(j)  (1280 + 64 * (j))
#define XB_XGEN(j)  (2304 + 64 * (j))
#define XB_TOP      3328
#define XB_TOPGEN   3392
#define XCD_BAR_WORDS 3456
#define XB_SPIN_CAP (1u << 22)
__device__ __forceinline__ unsigned xb_ld(unsigned* p)              { return __hip_atomic_load(p, __ATOMIC_RELAXED, __HIP_MEMORY_SCOPE_AGENT); }
__device__ __forceinline__ unsigned xb_add(unsigned* p, unsigned v) { return __hip_atomic_fetch_add(p, v, __ATOMIC_RELAXED, __HIP_MEMORY_SCOPE_AGENT); }
__device__ __forceinline__ unsigned xb_xcc_id() { return (unsigned)__builtin_amdgcn_s_getreg((3 << 11) | 20) & 0xFu; }
#define XB_SPIN(cond, bar) do { unsigned _sp = 0; while (cond) { __builtin_amdgcn_s_sleep(1); \
    if ((++_sp & 255u) == 0u) { if (xb_ld(&(bar)[XB_TMO])) break; if (_sp > XB_SPIN_CAP) { atomicAdd(&(bar)[XB_TMO], 1u); break; } } } } while (0)
struct XcdBarrier { unsigned* bar; unsigned x; volatile LAS unsigned* st; };
__device__ __forceinline__ XcdBarrier xcd_barrier_post(unsigned* bar, volatile LAS unsigned* st) {
    XcdBarrier b; b.bar = bar; b.x = xb_xcc_id(); b.st = st;
    if (threadIdx.x == 0) (void)xb_add(&bar[XB_XCNT(b.x)], 1u);
    return b;
}
__device__ __forceinline__ void xcd_barrier_complete(unsigned* bar, unsigned x, unsigned& nloc, unsigned& nx) {
    const unsigned G = gridDim.x * gridDim.y * gridDim.z;
    unsigned sum, cnt, mine, sp = 0u;
    for (;;) {
        sum = 0u; cnt = 0u; mine = 0u;
#pragma unroll
        for (unsigned j = 0; j < 16; ++j) { const unsigned c = xb_ld(&bar[XB_XCNT(j)]); sum += c; cnt += (c > 0u) ? 1u : 0u; mine = (j == x) ? c : mine; }
        if (sum == G) break;
        __builtin_amdgcn_s_sleep(1);
        if ((++sp & 255u) == 0u) { if (xb_ld(&bar[XB_TMO])) break; if (sp > XB_SPIN_CAP) { atomicAdd(&bar[XB_TMO], 1u); break; } }
    }
    nloc = mine > 0u ? mine : 1u; nx = cnt > 0u ? cnt : 1u;
}
__device__ __forceinline__ void xcd_barrier(const XcdBarrier& b) {
    asm volatile("s_waitcnt vmcnt(0)" ::: "memory");
    __syncthreads();
    if (threadIdx.x == 0) {
        unsigned* bar = b.bar;
        __builtin_amdgcn_s_waitcnt(0);
        unsigned nloc = b.st[0], nx = b.st[1];
        if (nloc == 0u) { xcd_barrier_complete(bar, b.x, nloc, nx); b.st[0] = nloc; b.st[1] = nx; }
        const unsigned old = xb_add(&bar[XB_XSUB(b.x)], 1u);
        const unsigned gen = old / nloc;
        if (old + 1u == (gen + 1u) * nloc) {
            __builtin_amdgcn_fence(__ATOMIC_RELEASE, "agent");
            asm volatile("s_waitcnt vmcnt(0)" ::: "memory");
            const unsigned og = xb_add(&bar[XB_TOP], 1u);
            const unsigned tg = og / nx;
            if (og + 1u == (tg + 1u) * nx) xb_add(&bar[XB_TOPGEN], 1u);
            else XB_SPIN(xb_ld(&bar[XB_TOPGEN]) == tg, bar);
            __builtin_amdgcn_fence(__ATOMIC_ACQUIRE, "agent");
            xb_add(&bar[XB_XGEN(b.x)], 1u);
            asm volatile("s_waitcnt vmcnt(0)" ::: "memory");
        } else {
            XB_SPIN(xb_ld(&bar[XB_XGEN(b.x)]) == gen, bar);
            __builtin_amdgcn_fence(__ATOMIC_ACQUIRE, "agent");
            asm volatile("s_waitcnt vmcnt(0)" ::: "memory");
        }
    }
    __syncthreads();
}

struct Frame {
    LAS unsigned char* lds;
    int tid, lane, wave, vcu, G;
    const float *xp, *xs, *st_in, *ck_in, *cv_in, *norm_in, *w_in, *lb_logits, *a_gnorm, *b_sinks, *w_pa, *w_pb, *w_out, *norm_final;
    float* out; unsigned char* ws;
    bf16 *Win_t, *Wpa_t, *Wpb_t, *Wout_t, *XN, *H; float *LB, *SSQ, *CKP, *CVP, *CKSN, *CVSN;
};

__device__ __forceinline__ float wave_sum(float v) {
#pragma unroll
    for (int o = 1; o < 64; o <<= 1) v += __shfl_xor(v, o);
    return v;
}

__device__ __forceinline__ void p0_transpose_item(const float* W, int K, int N, bf16* WT, LAS float* scr, int item, int lane) {
    const int nblk = N / 32, kb = item / nblk, nb = item % nblk, k0 = 64 * kb, n0 = 32 * nb;
#pragma unroll 8
    for (int i = 0; i < 32; ++i) { const int kk = 2 * i + (lane >> 5); scr[kk * 33 + (lane & 31)] = W[(size_t)(k0 + kk) * N + n0 + (lane & 31)]; }
    LDS_WAIT(); asm volatile("" ::: "memory");
    const int c = lane & 7;
#pragma unroll
    for (int j = 0; j < 4; ++j) { const int n = (lane >> 3) + 8 * j; const LAS float* s = scr + (8 * c) * 33 + n;
        v4u o; o.x = pk2(s[0 * 33], s[1 * 33]); o.y = pk2(s[2 * 33], s[3 * 33]); o.z = pk2(s[4 * 33], s[5 * 33]); o.w = pk2(s[6 * 33], s[7 * 33]);
        *(GAS v4u*)(WT + (size_t)(n0 + n) * K + k0 + 8 * c) = o; }
    LDS_WAIT(); asm volatile("" ::: "memory");
}
__device__ __forceinline__ void p0_prologue(Frame& F) {
    LAS float* scr = (LAS float*)(F.lds + F.wave * 16384);
    const int gw = F.vcu * NWAVES + F.wave, NGW = F.G * NWAVES;
    constexpr int I_IN = (D / 64) * (NIN / 32), I_SQ = (D / 64) * (D / 32);
    constexpr int NITEMS = I_IN + 3 * I_SQ;
    for (int it = gw; it < NITEMS; it += NGW) {
        int r = it;
        if (r < I_IN) { p0_transpose_item(F.w_in, D, NIN, F.Win_t, scr, r, F.lane); continue; } r -= I_IN;
        if (r < I_SQ) { p0_transpose_item(F.w_pa, D, D, F.Wpa_t, scr, r, F.lane); continue; } r -= I_SQ;
        if (r < I_SQ) { p0_transpose_item(F.w_pb, D, D, F.Wpb_t, scr, r, F.lane); continue; } r -= I_SQ;
        p0_transpose_item(F.w_out, D, D, F.Wout_t, scr, r, F.lane);
    }
    f32x4 gv[4];
#pragma unroll
    for (int j = 0; j < 4; ++j) gv[j] = ((const f32x4*)F.norm_in)[F.lane + 64 * j];
    for (int m = gw; m < M; m += NGW) {
        const float* xrow = m < MP ? F.xp + (size_t)m * D : F.xs + (size_t)(m - MP) * D;
        const f32x4* xr = (const f32x4*)xrow + F.lane;
        f32x4 v[4]; float s = 0.f;
#pragma unroll
        for (int j = 0; j < 4; ++j) { v[j] = xr[64 * j]; s += (v[j].x * v[j].x + v[j].y * v[j].y) + (v[j].z * v[j].z + v[j].w * v[j].w); }
        const float rstd = 1.0f / sqrtf(wave_sum(s) * (1.f / D) + EPS);
        unsigned long long* o8 = (unsigned long long*)(F.XN + (size_t)m * D) + F.lane;
#pragma unroll
        for (int j = 0; j < 4; ++j) o8[64 * j] = (unsigned long long)pk2(v[j].x * rstd * gv[j].x, v[j].y * rstd * gv[j].y) | ((unsigned long long)pk2(v[j].z * rstd * gv[j].z, v[j].w * rstd * gv[j].w) << 32);
    }
    { const int gt = F.vcu * 512 + F.tid; if (gt < D) { const float l0 = F.lb_logits[gt], l1 = F.lb_logits[D + gt]; F.LB[gt] = 1.0f / (1.0f + expf(l1 - l0)); } }
}

__device__ __forceinline__ void hgrn_slow_item(Frame& F, bool sample, int seq, int h) {
    LAS float* part = (LAS float*)F.lds; LAS float* red = part + 512;
    const int v = F.tid & 127, kq = F.tid >> 7;
    const int row0 = sample ? MP + seq * 4 : seq * SEQ, T = sample ? 4 : SEQ;
    float S[32];
#pragma unroll
    for (int j = 0; j < 32; ++j) S[j] = sample ? F.st_in[((size_t)(seq * 8 + h) * 128 + kq * 32 + j) * 128 + v] : 0.f;
    const float gn = F.a_gnorm[v];
    for (int t = 0; t < T; ++t) {
        bf16* hrow = F.H + (size_t)(row0 + t) * LDH;
        const float vv = bf2f(hrow[HC_VA + h * 128 + v]);
        float acc = 0.f;
#pragma unroll
        for (int j = 0; j < 32; ++j) { const int k = h * 128 + kq * 32 + j; const float q = bf2f(hrow[HC_QA + k]), f = __builtin_amdgcn_exp2f(h2f(hrow[HC_G2 + k]));
            S[j] = f * S[j] + (1.0f - f) * vv; acc += q * S[j]; }
        part[kq * 128 + v] = acc;
        __syncthreads();
        float o = 0.f;
        if (F.tid < 128) { o = (part[v] + part[128 + v]) + (part[256 + v] + part[384 + v]); const float ss = wave_sum(o * o); if (F.lane == 0) red[F.wave] = ss; }
        __syncthreads();
        if (F.tid < 128) { const float r = 1.0f / sqrtf((red[0] + red[1]) * (1.f / 128.f) + EPS);
            hrow[HC_HA + h * 128 + v] = (bf16)f2bf(o * r * gn * bf2f(hrow[HC_ZA + h * 128 + v])); }
    }
    float* so = F.out + (sample ? O_SS : O_SP) + ((size_t)(seq * 8 + h) * 128 + kq * 32) * 128 + v;
#pragma unroll
    for (int j = 0; j < 32; ++j) so[(size_t)j * 128] = S[j];
    __syncthreads();
}
__device__ __forceinline__ float bfw_lo(unsigned w) { return __uint_as_float(w << 16); }
__device__ __forceinline__ float bfw_hi(unsigned w) { return __uint_as_float(w & 0xffff0000u); }
__device__ __forceinline__ void swa_slow(Frame& F, int first, int stride) {
    for (int idx = first; idx < M * 16; idx += stride) {
        const int m = idx >> 4, head = idx & 15, kvh = head >> 3;
        bf16* qp = F.H + (size_t)m * LDH + HC_QB + head * 64;
        float q[64], o[64];
#pragma unroll
        for (int c = 0; c < 8; ++c) { const v4u w = *(const v4u*)(qp + 8 * c);
            q[8 * c + 0] = bfw_lo(w.x); q[8 * c + 1] = bfw_hi(w.x); q[8 * c + 2] = bfw_lo(w.y); q[8 * c + 3] = bfw_hi(w.y); q[8 * c + 4] = bfw_lo(w.z); q[8 * c + 5] = bfw_hi(w.z); q[8 * c + 6] = bfw_lo(w.w); q[8 * c + 7] = bfw_hi(w.w); }
#pragma unroll
        for (int d = 0; d < 64; ++d) o[d] = 0.f;
        const float slope2 = __builtin_amdgcn_exp2f(-0.5f * (float)(head + 1)) * LOG2E;
        float mx = F.b_sinks[head] * LOG2E, l = 1.0f;
        const bool sample = m >= MP;
        const int ms = m - MP, db = ms >> 2, t = sample ? (ms & 3) : (m & (SEQ - 1));
        const int nk = sample ? 128 : (t < 127 ? t + 1 : 128);
        for (int i = 0; i < nk; ++i) {
            int dist;
            if (sample && i < 127 - t) {
                const int j = t + 1 + i; dist = t + 128 - j;
                const float* kp = F.ck_in + ((size_t)(db * 128 + j) * 2 + kvh) * 64; const float* vp = F.cv_in + ((size_t)(db * 128 + j) * 2 + kvh) * 64;
                float sc = 0.f;
#pragma unroll
                for (int c = 0; c < 16; ++c) { const f32x4 w = *(const f32x4*)(kp + 4 * c); sc += (q[4 * c] * w.x + q[4 * c + 1] * w.y) + (q[4 * c + 2] * w.z + q[4 * c + 3] * w.w); }
                sc -= slope2 * (float)dist;
                const float mn = fmaxf(mx, sc), a = __builtin_amdgcn_exp2f(mx - mn), p = __builtin_amdgcn_exp2f(sc - mn);
                l = l * a + p; mx = mn;
#pragma unroll
                for (int c = 0; c < 16; ++c) { const f32x4 w = *(const f32x4*)(vp + 4 * c);
                    o[4 * c] = o[4 * c] * a + p * w.x; o[4 * c + 1] = o[4 * c + 1] * a + p * w.y; o[4 * c + 2] = o[4 * c + 2] * a + p * w.z; o[4 * c + 3] = o[4 * c + 3] * a + p * w.w; }
            } else {
                int srow; if (sample) { const int s = i - (127 - t); dist = t - s; srow = MP + db * 4 + s; } else { const int s = t - nk + 1 + i; dist = t - s; srow = m - dist; }
                const bf16* kp = F.H + (size_t)srow * LDH + HC_KB + kvh * 64; const bf16* vp = F.H + (size_t)srow * LDH + HC_VB + kvh * 64;
                float sc = 0.f;
#pragma unroll
                for (int c = 0; c < 8; ++c) { const v4u w = *(const v4u*)(kp + 8 * c);
                    sc += (q[8 * c] * bfw_lo(w.x) + q[8 * c + 1] * bfw_hi(w.x)) + (q[8 * c + 2] * bfw_lo(w.y) + q[8 * c + 3] * bfw_hi(w.y)) + (q[8 * c + 4] * bfw_lo(w.z) + q[8 * c + 5] * bfw_hi(w.z)) + (q[8 * c + 6] * bfw_lo(w.w) + q[8 * c + 7] * bfw_hi(w.w)); }
                sc -= slope2 * (float)dist;
                const float mn = fmaxf(mx, sc), a = __builtin_amdgcn_exp2f(mx - mn), p = __builtin_amdgcn_exp2f(sc - mn);
                l = l * a + p; mx = mn;
#pragma unroll
                for (int c = 0; c < 8; ++c) { const v4u w = *(const v4u*)(vp + 8 * c);
                    o[8 * c] = o[8 * c] * a + p * bfw_lo(w.x); o[8 * c + 1] = o[8 * c + 1] * a + p * bfw_hi(w.x); o[8 * c + 2] = o[8 * c + 2] * a + p * bfw_lo(w.y); o[8 * c + 3] = o[8 * c + 3] * a + p * bfw_hi(w.y);
                    o[8 * c + 4] = o[8 * c + 4] * a + p * bfw_lo(w.z); o[8 * c + 5] = o[8 * c + 5] * a + p * bfw_hi(w.z); o[8 * c + 6] = o[8 * c + 6] * a + p * bfw_lo(w.w); o[8 * c + 7] = o[8 * c + 7] * a + p * bfw_hi(w.w); }
            }
        }
        const float rl = 1.0f / l; const bf16* zp = F.H + (size_t)m * LDH + HC_ZB + head * 64;
#pragma unroll
        for (int c = 0; c < 8; ++c) { const v4u z = *(const v4u*)(zp + 8 * c); v4u w;
            w.x = pk2(o[8 * c] * rl * bfw_lo(z.x), o[8 * c + 1] * rl * bfw_hi(z.x)); w.y = pk2(o[8 * c + 2] * rl * bfw_lo(z.y), o[8 * c + 3] * rl * bfw_hi(z.y));
            w.z = pk2(o[8 * c + 4] * rl * bfw_lo(z.z), o[8 * c + 5] * rl * bfw_hi(z.z)); w.w = pk2(o[8 * c + 6] * rl * bfw_lo(z.w), o[8 * c + 7] * rl * bfw_hi(z.w));
            *(v4u*)(qp + 8 * c) = w; }
    }
}
__device__ __forceinline__ void p2_mixers_slow(Frame& F) {
    const int bx = blockIdx.x;
    if (bx < 64) hgrn_slow_item(F, false, bx >> 3, bx & 7);
    else for (int it = bx - 64; it < 1024; it += F.G - 64) hgrn_slow_item(F, true, it >> 3, it & 7);
    swa_slow(F, bx * 512 + F.tid, F.G * 512);
}

__device__ __forceinline__ void p5_final_norm(Frame& F) {
    const int gw = F.vcu * NWAVES + F.wave, NGW = F.G * NWAVES;
    f32x4 gv[4];
#pragma unroll
    for (int j = 0; j < 4; ++j) gv[j] = ((const f32x4*)F.norm_final)[F.lane + 64 * j];
    for (int m = gw; m < M; m += NGW) {
        float s = F.lane < 16 ? F.SSQ[(size_t)m * 16 + F.lane] : 0.f;
        s += __shfl_xor(s, 1); s += __shfl_xor(s, 2); s += __shfl_xor(s, 4); s += __shfl_xor(s, 8);
        s = __shfl(s, 0);
        const float rstd = 1.0f / sqrtf(s * (1.f / D) + EPS);
        const f32x4* yt = (const f32x4*)(F.H + (size_t)m * LDH + HC_QB) + F.lane; f32x4* yr = (f32x4*)(F.out + O_Y + (size_t)m * D) + F.lane;
#pragma unroll
        for (int j = 0; j < 4; ++j) { f32x4 y = yt[64 * j]; y = y * rstd * gv[j]; yr[64 * j] = y; }
    }
    { const int gt = F.vcu * 512 + F.tid, NT = F.G * 512;
      for (int i = gt; i < 128 * 128 * 32; i += NT) { const int c4 = (i & 31) * 4, rl = i >> 5, db = rl >> 7, l = rl & 127; const size_t dof = (size_t)rl * 128 + c4;
          f32x4 k, v; if (l < 124) { const size_t so = (size_t)(rl + 4) * 128 + c4; k = *(const f32x4*)(F.ck_in + so); v = *(const f32x4*)(F.cv_in + so); }
          else { const size_t so = (size_t)(db * 4 + (l - 124)) * 128 + c4; k = *(const f32x4*)(F.CKSN + so); v = *(const f32x4*)(F.CVSN + so); }
          *(f32x4*)(F.out + O_CKS + dof) = k; *(f32x4*)(F.out + O_CVS + dof) = v; }
      for (int i = gt; i < 8 * 128 * 32; i += NT) { const size_t o = (size_t)i * 4; *(f32x4*)(F.out + O_CKP + o) = *(const f32x4*)(F.CKP + o); *(f32x4*)(F.out + O_CVP + o) = *(const f32x4*)(F.CVP + o); } }
}

struct Args { const float* in[14]; float* out; unsigned char* ws; int ph_lo, ph_hi, li, pad; };
__global__ void __launch_bounds__(NWAVES * 64, 2) fwd(Args args) {
    extern __shared__ __attribute__((aligned(16))) unsigned char lds[];
    Frame F;
    F.lds = (LAS unsigned char*)lds;
    F.tid = threadIdx.x; F.lane = F.tid & 63; F.wave = __builtin_amdgcn_readfirstlane(F.tid >> 6);
    F.G = gridDim.x; { const int bx = blockIdx.x; F.vcu = (F.G % 8 == 0) ? (bx % 8) * (F.G / 8) + bx / 8 : bx; }
    F.xp = args.in[0]; F.xs = args.in[1]; F.st_in = args.in[2]; F.ck_in = args.in[3]; F.cv_in = args.in[4]; F.norm_in = args.in[5]; F.w_in = args.in[6]; F.lb_logits = args.in[7];
    F.a_gnorm = args.in[8]; F.b_sinks = args.in[9]; F.w_pa = args.in[10]; F.w_pb = args.in[11]; F.w_out = args.in[12]; F.norm_final = args.in[13];
    F.out = args.out; F.ws = args.ws; unsigned char* ws = args.ws;
    F.Win_t = (bf16*)(ws + WS_WIN); F.Wpa_t = (bf16*)(ws + WS_WPA); F.Wpb_t = (bf16*)(ws + WS_WPB); F.Wout_t = (bf16*)(ws + WS_WOUT);
    F.XN = (bf16*)(ws + WS_XN); F.H = (bf16*)(ws + WS_H); F.LB = (float*)(ws + WS_LB); F.SSQ = (float*)(ws + WS_SSQ);
    F.CKP = (float*)(ws + WS_CKP); F.CVP = (float*)(ws + WS_CVP); F.CKSN = (float*)(ws + WS_CKSN); F.CVSN = (float*)(ws + WS_CVSN);
    volatile LAS unsigned* MISC = (volatile LAS unsigned*)(F.lds + MISC_OFF);
    for (int u = F.tid; u < (LDS_BYTES - LDSCTL_OFF) / 4; u += NWAVES * 64) ((LAS unsigned*)(F.lds + LDSCTL_OFF))[u] = 0u;
    __syncthreads();
    XcdBarrier bar; bar.bar = (unsigned*)(ws + WS_CTL) + CW_BAR; bar.x = 0; bar.st = nullptr;
    if (N_LAUNCHES == 1) bar = xcd_barrier_post((unsigned*)(ws + WS_CTL) + CW_BAR, MISC + 8);
    const int lo = args.ph_lo, hi = args.ph_hi;
#define IN(k) (lo <= (k) && (k) < hi)
#define SEAM(k) do { if (IN(k) && IN((k) + 1)) xcd_barrier(bar); } while (0)

    if (IN(0)) { p0_prologue(F); SEAM(0); }
    if (IN(1)) {
        pg8::Gemm g{F.XN, F.XN, F.Win_t, F.Win_t, D, D, D}; pg8::StaticOrder S; S.init(M, NMIX, F.G, (int)blockIdx.x, 0);
        pg8::EpiIn E{F.H, F.LB, F.CKP, F.CVP, F.CKSN, F.CVSN, 0};
        pg8::gemm_phase<pg8::EpiIn, pg8::StaticOrder>(F.lds, g, S, E);
        SEAM(1);
    }
    if (IN(2)) { p2_mixers_slow(F); SEAM(2); }
    if (IN(3)) { SEAM(3); }
    if (IN(4)) {
        pg8::Gemm g{F.XN, F.XN, F.Win_t + (size_t)NMIX * D, F.Win_t + (size_t)NMIX * D, D, D, D}; pg8::StaticOrder S; S.init(M, 2048, F.G, (int)blockIdx.x, 0);
        pg8::EpiIn E{F.H, F.LB, F.CKP, F.CVP, F.CKSN, F.CVSN, 1};
        pg8::gemm_phase<pg8::EpiIn, pg8::StaticOrder>(F.lds, g, S, E);
        SEAM(4);
    }
    if (IN(5)) {
        pg8::Gemm g{F.H + HC_HA, F.H + HC_HB, F.Wpa_t, F.Wpb_t, LDH, D, D}; pg8::StaticOrder S; S.init(M, D, F.G, (int)blockIdx.x, 1);
        pg8::EpiMerge E{F.H, F.H + HC_MG};
        pg8::gemm_phase<pg8::EpiMerge, pg8::StaticOrder>(F.lds, g, S, E);
        SEAM(5);
    }
    if (IN(6)) {
        pg8::Gemm g{F.H + HC_MG, F.H + HC_MG, F.Wout_t, F.Wout_t, LDH, D, D}; pg8::StaticOrder S; S.init(M, D, F.G, (int)blockIdx.x, 0);
        pg8::EpiOut E{F.xp, F.xs, F.H + HC_QB, F.SSQ};
        pg8::gemm_phase<pg8::EpiOut, pg8::StaticOrder>(F.lds, g, S, E);
        SEAM(6);
    }
    if (IN(7)) { p5_final_norm(F); }
#undef IN
#undef SEAM
}

extern "C" void kernel_launch(void* const* d_in, const int* in_sizes, int n_in, void* d_out, int out_size, void* d_ws, size_t ws_size, hipStream_t stream) {
    static int grid = 0;
    if (grid == 0) {
        if (n_in != 14 || (size_t)out_size != O_END || ws_size < WS_END) { fprintf(stderr, "kernel_launch: unexpected shapes: n_in %d out %d ws %zu (need %zu)\n", n_in, out_size, ws_size, (size_t)WS_END); grid = -1; return; }
        int dev = 0, cus = 0;
        if (hipGetDevice(&dev) != hipSuccess || hipDeviceGetAttribute(&cus, hipDeviceAttributeMultiprocessorCount, dev) != hipSuccess) { grid = -1; return; }
        if (hipFuncSetAttribute((const void*)fwd, hipFuncAttributeMaxDynamicSharedMemorySize, LDS_BYTES) != hipSuccess) { fprintf(stderr, "kernel_launch: hipFuncSetAttribute failed\n"); grid = -1; return; }
        int per_cu = 0;
        (void)hipOccupancyMaxActiveBlocksPerMultiprocessor(&per_cu, (const void*)fwd, NWAVES * 64, LDS_BYTES);
        (void)hipGetLastError();
        grid = cus;
    }
    if (grid < 0) return;
    (void)hipMemsetAsync((char*)d_ws + WS_CTL, 0, CTL_ZERO_BYTES, stream);
    Args a{};
    for (int i = 0; i < 14; ++i) a.in[i] = (const float*)d_in[i];
    a.out = (float*)d_out; a.ws = (unsigned char*)d_ws;
    for (int li = 0; li < N_LAUNCHES; ++li) {
        a.ph_lo = (N_LAUNCHES == 1) ? 0 : li; a.ph_hi = (N_LAUNCHES == 1) ? NPHASE : li + 1; a.li = li;
        hipLaunchKernelGGL(fwd, dim3(grid), dim3(NWAVES * 64), LDS_BYTES, stream, a);
    }
}
```

```cpp
#include <hip/hip_runtime.h>
#include <cstdio>
#include <cstdint>

#ifndef MK_N_LAUNCHES
#define MK_N_LAUNCHES 1
#endif

constexpr int D = 1024, MP = 32768, MS = 512, M = MP + MS, SEQ = 4096, NIN = 8448;
constexpr int LDH = 6400;
constexpr int HC_QA = 0, HC_G2 = 1024, HC_VA = 2048, HC_ZA = 3072, HC_QB = 4096, HC_KB = 5120, HC_VB = 5248, HC_ZB = 5376;
constexpr int HC_HA = HC_VA, HC_HB = HC_QB, HC_GA = 0, HC_GB = 1024, HC_MG = HC_ZA;
constexpr int NMIX = 6400;
constexpr float EPS = 1e-6f, LOG2E = 1.4426950408889634f, C2 = 0.125f * 1.4426950408889634f;
constexpr size_t O_Y = 0, O_SP = 34078720, O_CKP = 35127296, O_CVP = 35258368, O_SS = 35389440, O_CKS = 52166656, O_CVS = 54263808, O_END = 56360960;
constexpr size_t MiB = 1u << 20;
constexpr size_t WS_CTL = 0, CTL_ZERO_BYTES = 1 * MiB;
constexpr size_t WS_LB = 1 * MiB;
constexpr size_t WS_CKP = 1 * MiB + 65536, WS_CVP = WS_CKP + 524288, WS_CKSN = WS_CVP + 524288, WS_CVSN = WS_CKSN + 262144;
constexpr size_t WS_WIN = 3 * MiB;
constexpr size_t WS_WPA = 20 * MiB, WS_WPB = 22 * MiB, WS_WOUT = 24 * MiB;
constexpr size_t WS_XN = 26 * MiB;
constexpr size_t WS_SSQ = 26 * MiB;
constexpr size_t WS_H = 91 * MiB;
constexpr size_t WS_END = WS_H + (size_t)M * LDH * 2;
static_assert(WS_CVSN + 262144 <= WS_WIN && WS_XN + (size_t)M * D * 2 <= WS_H && WS_END <= 512 * MiB, "ws map");

namespace pg8 {
#define PG8_LAS __attribute__((address_space(3)))
typedef unsigned short bf16_t;
typedef short bf16x8 __attribute__((ext_vector_type(8)));
typedef float f32x4 __attribute__((ext_vector_type(4)));
typedef unsigned u32x4 __attribute__((ext_vector_type(4)));
constexpr int BM = 256, BK = 64, HALF = 128, HTB = HALF * BK * 2, STAGE_BYTES = 8 * HTB, NXCD = 8, WGM = 8;

__host__ __device__ __forceinline__ int lds_byte(int r, int c) { const int st = (r >> 4) * 2 + (c >> 5), rr = r & 15, cc = c & 31, ob = rr * 64 + cc * 2; return st * 1024 + (ob ^ (((ob >> 9) & 1) << 5)); }
__host__ __device__ __forceinline__ void stage_rc(int b, int& R, int& C) { const int st = b / 1024, sb = b % 1024, swz = sb ^ (((sb >> 9) & 1) << 5); R = (st >> 1) * 16 + swz / 64; C = (st & 1) * 32 + (swz % 64) / 2; }
__host__ __device__ __forceinline__ int perm32(int rho) { const int n = rho >> 4, i = rho & 15; return 8 * (i >> 2) + 4 * n + (i & 3); }

struct Unit { int pm, pn, sub; };
struct Gemm { const bf16_t *A0, *A1, *B0, *B1; int lda, ldb, K; };

struct StaticOrder {
    int nM, nN, nwg, G, c, dbl;
    __host__ __device__ void init(int M_, int N_, int G_, int c_, int dbl_) { nM = M_ / BM; nN = N_ / BM; nwg = nM * nN; G = G_; c = c_; dbl = dbl_; }
    __host__ __device__ bool next(int i, Unit& u) const {
        const int it = dbl ? (i >> 1) : i; u.sub = dbl ? (i & 1) : 0;
        const long L = (long)it * G + c; if (L >= nwg) return false;
        int wgid = (int)L; { const int q = nwg / NXCD, r = nwg % NXCD, xcd = wgid % NXCD, off = wgid / NXCD; wgid = (xcd < r ? xcd * (q + 1) : r * (q + 1) + (xcd - r) * q) + off; }
        const int nig = WGM * nN, gid = wgid / nig, fm = gid * WGM, gsz = (nM - fm) < WGM ? (nM - fm) : WGM;
        u.pm = fm + ((wgid % nig) % gsz); u.pn = (wgid % nig) / gsz; return true;
    }
};

typedef float f32x2_t __attribute__((ext_vector_type(2))); typedef __bf16 bf16x2_t __attribute__((ext_vector_type(2)));
__device__ __forceinline__ unsigned cvt_pk_bf16(float lo, float hi) { f32x2_t v = {lo, hi}; bf16x2_t b = __builtin_convertvector(v, bf16x2_t); return __builtin_bit_cast(unsigned, b); }
__device__ __forceinline__ float bf_lo(unsigned w) { return __uint_as_float(w << 16); }
__device__ __forceinline__ float bf_hi(unsigned w) { return __uint_as_float(w & 0xffff0000u); }

typedef f32x4 Acc[2][2][4][2];

template <class Epi, class Sched>
__device__ __forceinline__ void gemm_phase(PG8_LAS unsigned char* lds, const Gemm g, const Sched& S, const Epi& E) {
    const int tid = threadIdx.x, wid = __builtin_amdgcn_readfirstlane(tid >> 6), lane = tid & 63, wr = wid >> 2, wc = wid & 3, fr = lane & 15, fq = lane >> 4;
    const int K = g.K, nt = K / BK;
    unsigned voffA[2], voffB[2];
#pragma unroll
    for (int i = 0; i < 2; ++i) { int R, C; stage_rc(tid * 16 + i * 8192, R, C); const int Rb = Epi::PERM ? ((R & ~31) + perm32(R & 31)) : R;
        voffA[i] = (unsigned)(R * g.lda + C) * 2u; voffB[i] = (unsigned)(Rb * g.ldb + C) * 2u; }
    const size_t kstep = (size_t)(BK * 2);
    const size_t hstepA = (size_t)HALF * g.lda * 2, hstepB = (size_t)HALF * g.ldb * 2;
    const size_t tstepA = 2 * hstepA, tstepB = 2 * hstepB;
    const unsigned ldsw = (unsigned)wid * 1024u;
    const int aoff = lds_byte(wr * 64 + fr, fq * 8), boff = lds_byte(wc * 32 + fr, fq * 8);
#define PG8_SA(b, h) (((b) * 2 + (h)) * HTB)
#define PG8_SB(b, h) ((4 + (b) * 2 + (h)) * HTB)
#define PG8_STAGE(bufoff, gbase, voff) do { _Pragma("unroll") for (int _i = 0; _i < 2; ++_i) \
        __builtin_amdgcn_global_load_lds((const unsigned*)((const char*)(gbase) + (voff)[_i]), (PG8_LAS unsigned*)(lds + (bufoff) + ldsw + _i * 8192), 16, 0, 0); } while (0)
#define PG8_LDA(dst, b, h) do { _Pragma("unroll") for (int m = 0; m < 4; ++m) _Pragma("unroll") for (int k = 0; k < 2; ++k) dst[m][k] = *(const PG8_LAS bf16x8*)(lds + PG8_SA(b, h) + aoff + m * 2048 + k * 1024); } while (0)
#define PG8_LDB(dst, b, h) do { _Pragma("unroll") for (int n = 0; n < 2; ++n) _Pragma("unroll") for (int k = 0; k < 2; ++k) dst[n][k] = *(const PG8_LAS bf16x8*)(lds + PG8_SB(b, h) + boff + n * 2048 + k * 1024); } while (0)
#define PG8_MMA(ai, bj, At, Bt) do { __builtin_amdgcn_s_setprio(1); _Pragma("unroll") for (int m = 0; m < 4; ++m) _Pragma("unroll") for (int n = 0; n < 2; ++n) _Pragma("unroll") for (int k = 0; k < 2; ++k) \
        acc[ai][bj][m][n] = __builtin_amdgcn_mfma_f32_16x16x32_bf16(Bt[n][k], At[m][k], acc[ai][bj][m][n], 0, 0, 0); __builtin_amdgcn_s_setprio(0); } while (0)
#define PG8_WAIT_V(n) asm volatile("s_waitcnt vmcnt(" #n ")" ::: "memory")
#define PG8_WAIT_L(n) asm volatile("s_waitcnt lgkmcnt(" #n ")" ::: "memory")
#define PG8_BAR __builtin_amdgcn_s_barrier()
#define PG8_SCHED __builtin_amdgcn_sched_barrier(0)
    Unit cur, nxt; int ui = 0;
    if (!S.next(0, cur)) return;
    Acc acc;
#pragma unroll
    for (int a = 0; a < 2; ++a)
#pragma unroll
        for (int b = 0; b < 2; ++b)
#pragma unroll
            for (int m = 0; m < 4; ++m)
#pragma unroll
                for (int n = 0; n < 2; ++n) acc[a][b][m][n] = (f32x4){0.f, 0.f, 0.f, 0.f};
    bf16x8 At[4][2], B0[2][2], B1[2][2];
    const char* cA = (const char*)(cur.sub ? g.A1 : g.A0) + (size_t)cur.pm * tstepA; const char* cB = (const char*)(cur.sub ? g.B1 : g.B0) + (size_t)cur.pn * tstepB;
    PG8_STAGE(PG8_SB(0, 0), cB, voffB); PG8_STAGE(PG8_SB(0, 1), cB + hstepB, voffB); PG8_STAGE(PG8_SA(0, 0), cA, voffA); PG8_STAGE(PG8_SA(0, 1), cA + hstepA, voffA);
    if (wr == 1) PG8_BAR;
    PG8_WAIT_V(2); PG8_BAR;
    PG8_STAGE(PG8_SB(1, 0), cB + kstep, voffB); PG8_STAGE(PG8_SA(1, 0), cA + kstep, voffA); PG8_STAGE(PG8_SB(1, 1), cB + hstepB + kstep, voffB);
    PG8_WAIT_V(6); PG8_BAR;
    for (;;) {
        const bool has_next = S.next(ui + 1, nxt);
        const char* nA = has_next ? (const char*)(nxt.sub ? g.A1 : g.A0) + (size_t)nxt.pm * tstepA : cA; const char* nB = has_next ? (const char*)(nxt.sub ? g.B1 : g.B0) + (size_t)nxt.pn * tstepB : cB;
        for (int t = 0; t < nt; t += 2) {
            const bool last = (t == nt - 2);
            const char* a1 = cA + (size_t)(t + 1) * kstep;
            const char* a2 = last ? nA : cA + (size_t)(t + 2) * kstep; const char* b2 = last ? nB : cB + (size_t)(t + 2) * kstep;
            const char* a3 = a2 + kstep; const char* b3 = b2 + kstep;
            PG8_LDB(B0, 0, 0); PG8_LDB(B1, 0, 1); PG8_SCHED; PG8_LDA(At, 0, 0); PG8_STAGE(PG8_SA(1, 1), a1 + hstepA, voffA);
            PG8_WAIT_V(8); PG8_WAIT_L(0); PG8_BAR; PG8_MMA(0, 0, At, B0); PG8_MMA(0, 1, At, B1); PG8_BAR; PG8_SCHED;
            PG8_LDA(At, 0, 1); PG8_STAGE(PG8_SB(0, 0), b2, voffB); PG8_STAGE(PG8_SB(0, 1), b2 + hstepB, voffB); PG8_STAGE(PG8_SA(0, 0), a2, voffA);
            PG8_WAIT_V(8); PG8_WAIT_L(0); PG8_BAR; PG8_MMA(1, 0, At, B0); PG8_MMA(1, 1, At, B1); PG8_BAR; PG8_SCHED;
            PG8_LDB(B0, 1, 0); PG8_LDB(B1, 1, 1); PG8_SCHED; PG8_LDA(At, 1, 0); PG8_STAGE(PG8_SA(0, 1), a2 + hstepA, voffA);
            PG8_WAIT_V(8); PG8_WAIT_L(0); PG8_BAR; PG8_MMA(0, 0, At, B0); PG8_MMA(0, 1, At, B1); PG8_BAR; PG8_SCHED;
            PG8_LDA(At, 1, 1); PG8_STAGE(PG8_SB(1, 0), b3, voffB); PG8_STAGE(PG8_SB(1, 1), b3 + hstepB, voffB); PG8_STAGE(PG8_SA(1, 0), a3, voffA);
            PG8_WAIT_V(8); PG8_WAIT_L(0); PG8_BAR; PG8_MMA(1, 0, At, B0); PG8_MMA(1, 1, At, B1); PG8_BAR; PG8_SCHED;
        }
        if (wr == 0) PG8_BAR;
        const bool keep = E(acc, cur, wr, wc, fr, fq);
        if (!has_next) break;
        if (!keep) {
#pragma unroll
        for (int a = 0; a < 2; ++a)
#pragma unroll
            for (int b = 0; b < 2; ++b)
#pragma unroll
                for (int m = 0; m < 4; ++m)
#pragma unroll
                    for (int n = 0; n < 2; ++n) acc[a][b][m][n] = (f32x4){0.f, 0.f, 0.f, 0.f};
        }
        cur = nxt; cA = nA; cB = nB; ++ui;
        if (wr == 1) PG8_BAR;
    }
    PG8_WAIT_V(0);
    PG8_BAR;
#undef PG8_SA
#undef PG8_SB
#undef PG8_STAGE
#undef PG8_LDA
#undef PG8_LDB
#undef PG8_MMA
#undef PG8_WAIT_V
#undef PG8_WAIT_L
#undef PG8_BAR
#undef PG8_SCHED
}

__device__ __forceinline__ float sigmoidf_(float x) { return __builtin_amdgcn_rcpf(1.0f + __builtin_amdgcn_exp2f(-x * LOG2E)); }
__device__ __forceinline__ float siluf_(float x) { return x * sigmoidf_(x); }
__device__ __forceinline__ unsigned cvt_pk_f16(float lo, float hi) { typedef _Float16 h2 __attribute__((ext_vector_type(2))); h2 v; v.x = (_Float16)lo; v.y = (_Float16)hi; return __builtin_bit_cast(unsigned, v); }

struct EpiIn {
    static constexpr bool PERM = true;
    bf16_t* H; const float* lb; float *ckp, *cvp, *cksn, *cvsn; int gate;
    template <int MODE> __device__ __forceinline__ void run(Acc& acc, const Unit& u, int wr, int wc, int fr, int fq) const {
        const int row0 = u.pm * BM + wr * 64 + fr, cb = wc * 32 + 8 * fq;
        bf16_t* base; int ld;
        base = H + u.pn * 256 + cb; ld = LDH;
        float lbv[2][8];
        if (MODE == 2) {
#pragma unroll
            for (int bj = 0; bj < 2; ++bj) { const f32x4 a = *(const f32x4*)(lb + (u.pn - 4) * 256 + bj * HALF + cb), b = *(const f32x4*)(lb + (u.pn - 4) * 256 + bj * HALF + cb + 4);
                lbv[bj][0] = a[0]; lbv[bj][1] = a[1]; lbv[bj][2] = a[2]; lbv[bj][3] = a[3]; lbv[bj][4] = b[0]; lbv[bj][5] = b[1]; lbv[bj][6] = b[2]; lbv[bj][7] = b[3]; }
        }
#pragma unroll
        for (int ai = 0; ai < 2; ++ai)
#pragma unroll
            for (int m = 0; m < 4; ++m) { const int row = row0 + ai * HALF + m * 16; bf16_t* rowp = base + (size_t)row * ld;
#pragma unroll
                for (int bj = 0; bj < 2; ++bj) { float v[8];
#pragma unroll
                    for (int j = 0; j < 4; ++j) { v[j] = acc[ai][bj][m][0][j]; v[4 + j] = acc[ai][bj][m][1][j]; }
                    if (MODE == 5) {
                        float* dst = nullptr;
                        if (row < MP) { const int t = row & (SEQ - 1); if (t >= SEQ - 128) dst = (bj ? cvp : ckp) + ((size_t)((row >> 12) * 128 + (t - (SEQ - 128))) * 128 + cb); }
                        else { const int ms = row - MP; dst = (bj ? cvsn : cksn) + ((size_t)ms * 128 + cb); }
                        if (dst) { *(f32x4*)dst = acc[ai][bj][m][0]; *(f32x4*)(dst + 4) = acc[ai][bj][m][1]; }
                    }
                    u32x4 w;
                    if (MODE == 2) {
#pragma unroll
                        for (int j = 0; j < 8; ++j) { const float l = lbv[bj][j]; v[j] = __builtin_amdgcn_logf(l + (1.0f - l) * sigmoidf_(v[j])); }
                        w.x = cvt_pk_f16(v[0], v[1]); w.y = cvt_pk_f16(v[2], v[3]); w.z = cvt_pk_f16(v[4], v[5]); w.w = cvt_pk_f16(v[6], v[7]);
                    } else {
#pragma unroll
                        for (int j = 0; j < 8; ++j) { if (MODE == 1) v[j] = siluf_(v[j]); if (MODE == 3) v[j] *= C2; if (MODE == 4) v[j] = sigmoidf_(v[j]); }
                        w.x = cvt_pk_bf16(v[0], v[1]); w.y = cvt_pk_bf16(v[2], v[3]); w.z = cvt_pk_bf16(v[4], v[5]); w.w = cvt_pk_bf16(v[6], v[7]);
                    }
                    *(u32x4*)(rowp + bj * HALF) = w; } }
    }
    __device__ __forceinline__ bool operator()(Acc& acc, const Unit& u, int wr, int wc, int fr, int fq) const {
        const int pn = u.pn;
        if (gate) { run<4>(acc, u, wr, wc, fr, fq); return false; }
        if (pn < 4) run<1>(acc, u, wr, wc, fr, fq);
        else if (pn < 8) run<2>(acc, u, wr, wc, fr, fq);
        else if (pn < 12) run<0>(acc, u, wr, wc, fr, fq);
        else if (pn < 16) run<1>(acc, u, wr, wc, fr, fq);
        else if (pn < 20) run<3>(acc, u, wr, wc, fr, fq);
        else if (pn == 20) run<5>(acc, u, wr, wc, fr, fq);
        else run<1>(acc, u, wr, wc, fr, fq);
        return false;
    }
};

struct EpiMerge {
    static constexpr bool PERM = true;
    const bf16_t* HG; bf16_t* MG;
    __device__ __forceinline__ bool operator()(Acc& acc, const Unit& u, int wr, int wc, int fr, int fq) const {
        const int row0 = u.pm * BM + wr * 64 + fr, col0 = u.pn * BM + wc * 32 + 8 * fq;
#pragma unroll
        for (int ai = 0; ai < 2; ++ai)
#pragma unroll
            for (int m = 0; m < 4; ++m) { const int row = row0 + ai * HALF + m * 16; const bf16_t* gp = HG + (size_t)row * LDH + col0;
#pragma unroll
                for (int bj = 0; bj < 2; ++bj) {
                    const u32x4 gb = *(const u32x4*)(gp + 1024 + bj * HALF);
                    float b[8] = {bf_lo(gb.x), bf_hi(gb.x), bf_lo(gb.y), bf_hi(gb.y), bf_lo(gb.z), bf_hi(gb.z), bf_lo(gb.w), bf_hi(gb.w)};
                    if (u.sub == 0) {
                        const u32x4 ga = *(const u32x4*)(gp + bj * HALF);
                        float a[8] = {bf_lo(ga.x), bf_hi(ga.x), bf_lo(ga.y), bf_hi(ga.y), bf_lo(ga.z), bf_hi(ga.z), bf_lo(ga.w), bf_hi(ga.w)};
#pragma unroll
                        for (int j = 0; j < 4; ++j) { acc[ai][bj][m][0][j] *= a[j] * __builtin_amdgcn_rcpf(b[j]); acc[ai][bj][m][1][j] *= a[4 + j] * __builtin_amdgcn_rcpf(b[4 + j]); }
                    } else {
                        float v[8];
#pragma unroll
                        for (int j = 0; j < 4; ++j) { v[j] = acc[ai][bj][m][0][j] * b[j]; v[4 + j] = acc[ai][bj][m][1][j] * b[4 + j]; }
                        u32x4 w; w.x = cvt_pk_bf16(v[0], v[1]); w.y = cvt_pk_bf16(v[2], v[3]); w.z = cvt_pk_bf16(v[4], v[5]); w.w = cvt_pk_bf16(v[6], v[7]);
                        *(u32x4*)(MG + (size_t)row * LDH + col0 + bj * HALF) = w;
                    } } }
        return u.sub == 0;
    }
};

struct EpiOut {
    static constexpr bool PERM = false;
    const float* xp; const float* xs; bf16_t* YT; float* SSQ;
    __device__ __forceinline__ bool operator()(Acc& acc, const Unit& u, int wr, int wc, int fr, int fq) const {
        const int row0 = u.pm * BM + wr * 64 + fr, col0 = u.pn * BM + wc * 32 + 4 * fq;
#pragma unroll
        for (int ai = 0; ai < 2; ++ai)
#pragma unroll
            for (int m = 0; m < 4; ++m) { const int row = row0 + ai * HALF + m * 16;
                const float* xr = (row < MP ? xp + (size_t)row * D : xs + (size_t)(row - MP) * D) + col0; float* yr = (float*)(YT + (size_t)row * LDH) + col0; float ss = 0.f;
#pragma unroll
                for (int bj = 0; bj < 2; ++bj)
#pragma unroll
                    for (int n = 0; n < 2; ++n) { const f32x4 y = *(const f32x4*)(xr + bj * HALF + n * 16) + acc[ai][bj][m][n]; *(f32x4*)(yr + bj * HALF + n * 16) = y;
                        ss += (y[0] * y[0] + y[1] * y[1]) + (y[2] * y[2] + y[3] * y[3]); }
                ss += __shfl_xor(ss, 16); ss += __shfl_xor(ss, 32);
                if (fq == 0) SSQ[(size_t)row * 16 + u.pn * 4 + wc] = ss; }
        return false;
    }
};
}

constexpr int NWAVES = 8;
constexpr int N_LAUNCHES = MK_N_LAUNCHES;
constexpr int NPHASE = 8;
constexpr int RING_BYTES = 131072, LDSCTL_OFF = RING_BYTES, MISC_OFF = LDSCTL_OFF + 320, LDS_BYTES = 147456;
constexpr int CW_BAR = 4096;

#define GAS __attribute__((address_space(1)))
#define LAS __attribute__((address_space(3)))
typedef unsigned short bf16;
typedef unsigned v4u __attribute__((ext_vector_type(4)));
typedef float f32x4 __attribute__((ext_vector_type(4)));
typedef GAS unsigned gu32;
#define RLX_AGENT __ATOMIC_RELAXED, __HIP_MEMORY_SCOPE_AGENT
#define LDS_WAIT() asm volatile("s_waitcnt lgkmcnt(0)" ::: "memory")
__device__ __forceinline__ unsigned f2bf(float f) { unsigned u = __builtin_bit_cast(unsigned, f); return (u + 0x7fffu + ((u >> 16) & 1u)) >> 16; }
__device__ __forceinline__ unsigned pk2(float lo, float hi) { return f2bf(lo) | (f2bf(hi) << 16); }
__device__ __forceinline__ float bf2f(bf16 h) { return __uint_as_float((unsigned)h << 16); }
__device__ __forceinline__ float h2f(bf16 h) { return (float)__builtin_bit_cast(_Float16, h); }

#define XB_TMO      128
#define XB_XCNT(j)  (256  + 64 * (j))
#define XB_XSUB(j)  (1280 + 64 * (j))
#define XB_XGEN(j)  (2304 + 64 * (j))
#define XB_TOP      3328
#define XB_TOPGEN   3392
#define XCD_BAR_WORDS 3456
#define XB_SPIN_CAP (1u << 22)
__device__ __forceinline__ unsigned xb_ld(unsigned* p)              { return __hip_atomic_load(p, __ATOMIC_RELAXED, __HIP_MEMORY_SCOPE_AGENT); }
__device__ __forceinline__ unsigned xb_add(unsigned* p, unsigned v) { return __hip_atomic_fetch_add(p, v, __ATOMIC_RELAXED, __HIP_MEMORY_SCOPE_AGENT); }
__device__ __forceinline__ unsigned xb_xcc_id() { return (unsigned)__builtin_amdgcn_s_getreg((3 << 11) | 20) & 0xFu; }
#define XB_SPIN(cond, bar) do { unsigned _sp = 0; while (cond) { __builtin_amdgcn_s_sleep(1); \
    if ((++_sp & 255u) == 0u) { if (xb_ld(&(bar)[XB_TMO])) break; if (_sp > XB_SPIN_CAP) { atomicAdd(&(bar)[XB_TMO], 1u); break; } } } } while (0)
struct XcdBarrier { unsigned* bar; unsigned x; volatile LAS unsigned* st; };
__device__ __forceinline__ XcdBarrier xcd_barrier_post(unsigned* bar, volatile LAS unsigned* st) {
    XcdBarrier b; b.bar = bar; b.x = xb_xcc_id(); b.st = st;
    if (threadIdx.x == 0) (void)xb_add(&bar[XB_XCNT(b.x)], 1u);
    return b;
}
__device__ __forceinline__ void xcd_barrier_complete(unsigned* bar, unsigned x, unsigned& nloc, unsigned& nx) {
    const unsigned G = gridDim.x * gridDim.y * gridDim.z;
    unsigned sum, cnt, mine, sp = 0u;
    for (;;) {
        sum = 0u; cnt = 0u; mine = 0u;
#pragma unroll
        for (unsigned j = 0; j < 16; ++j) { const unsigned c = xb_ld(&bar[XB_XCNT(j)]); sum += c; cnt += (c > 0u) ? 1u : 0u; mine = (j == x) ? c : mine; }
        if (sum == G) break;
        __builtin_amdgcn_s_sleep(1);
        if ((++sp & 255u) == 0u) { if (xb_ld(&bar[XB_TMO])) break; if (sp > XB_SPIN_CAP) { atomicAdd(&bar[XB_TMO], 1u); break; } }
    }
    nloc = mine > 0u ? mine : 1u; nx = cnt > 0u ? cnt : 1u;
}
__device__ __forceinline__ void xcd_barrier(const XcdBarrier& b) {
    asm volatile("s_waitcnt vmcnt(0)" ::: "memory");
    __syncthreads();
    if (threadIdx.x == 0) {
        unsigned* bar = b.bar;
        __builtin_amdgcn_s_waitcnt(0);
        unsigned nloc = b.st[0], nx = b.st[1];
        if (nloc == 0u) { xcd_barrier_complete(bar, b.x, nloc, nx); b.st[0] = nloc; b.st[1] = nx; }
        const unsigned old = xb_add(&bar[XB_XSUB(b.x)], 1u);
        const unsigned gen = old / nloc;
        if (old + 1u == (gen + 1u) * nloc) {
            __builtin_amdgcn_fence(__ATOMIC_RELEASE, "agent");
            asm volatile("s_waitcnt vmcnt(0)" ::: "memory");
            const unsigned og = xb_add(&bar[XB_TOP], 1u);
            const unsigned tg = og / nx;
            if (og + 1u == (tg + 1u) * nx) xb_add(&bar[XB_TOPGEN], 1u);
            else XB_SPIN(xb_ld(&bar[XB_TOPGEN]) == tg, bar);
            __builtin_amdgcn_fence(__ATOMIC_ACQUIRE, "agent");
            xb_add(&bar[XB_XGEN(b.x)], 1u);
            asm volatile("s_waitcnt vmcnt(0)" ::: "memory");
        } else {
            XB_SPIN(xb_ld(&bar[XB_XGEN(b.x)]) == gen, bar);
            __builtin_amdgcn_fence(__ATOMIC_ACQUIRE, "agent");
            asm volatile("s_waitcnt vmcnt(0)" ::: "memory");
        }
    }
    __syncthreads();
}

struct Frame {
    LAS unsigned char* lds;
    int tid, lane, wave, vcu, G;
    const float *xp, *xs, *st_in, *ck_in, *cv_in, *norm_in, *w_in, *lb_logits, *a_gnorm, *b_sinks, *w_pa, *w_pb, *w_out, *norm_final;
    float* out; unsigned char* ws;
    bf16 *Win_t, *Wpa_t, *Wpb_t, *Wout_t, *XN, *H; float *LB, *SSQ, *CKP, *CVP, *CKSN, *CVSN;
};

__device__ __forceinline__ float wave_sum(float v) {
#pragma unroll
    for (int o = 1; o < 64; o <<= 1) v += __shfl_xor(v, o);
    return v;
}

__device__ __forceinline__ void p0_transpose_item(const float* W, int K, int N, bf16* WT, LAS float* scr, int item, int lane) {
    const int nblk = N / 32, kb = item / nblk, nb = item % nblk, k0 = 64 * kb, n0 = 32 * nb;
#pragma unroll 8
    for (int i = 0; i < 32; ++i) { const int kk = 2 * i + (lane >> 5); scr[kk * 33 + (lane & 31)] = W[(size_t)(k0 + kk) * N + n0 + (lane & 31)]; }
    LDS_WAIT(); asm volatile("" ::: "memory");
    const int c = lane & 7;
#pragma unroll
    for (int j = 0; j < 4; ++j) { const int n = (lane >> 3) + 8 * j; const LAS float* s = scr + (8 * c) * 33 + n;
        v4u o; o.x = pk2(s[0 * 33], s[1 * 33]); o.y = pk2(s[2 * 33], s[3 * 33]); o.z = pk2(s[4 * 33], s[5 * 33]); o.w = pk2(s[6 * 33], s[7 * 33]);
        *(GAS v4u*)(WT + (size_t)(n0 + n) * K + k0 + 8 * c) = o; }
    LDS_WAIT(); asm volatile("" ::: "memory");
}
__device__ __forceinline__ void p0_prologue(Frame& F) {
    LAS float* scr = (LAS float*)(F.lds + F.wave * 16384);
    const int gw = F.vcu * NWAVES + F.wave, NGW = F.G * NWAVES;
    constexpr int I_IN = (D / 64) * (NIN / 32), I_SQ = (D / 64) * (D / 32);
    constexpr int NITEMS = I_IN + 3 * I_SQ;
    for (int it = gw; it < NITEMS; it += NGW) {
        int r = it;
        if (r < I_IN) { p0_transpose_item(F.w_in, D, NIN, F.Win_t, scr, r, F.lane); continue; } r -= I_IN;
        if (r < I_SQ) { p0_transpose_item(F.w_pa, D, D, F.Wpa_t, scr, r, F.lane); continue; } r -= I_SQ;
        if (r < I_SQ) { p0_transpose_item(F.w_pb, D, D, F.Wpb_t, scr, r, F.lane); continue; } r -= I_SQ;
        p0_transpose_item(F.w_out, D, D, F.Wout_t, scr, r, F.lane);
    }
    f32x4 gv[4];
#pragma unroll
    for (int j = 0; j < 4; ++j) gv[j] = ((const f32x4*)F.norm_in)[F.lane + 64 * j];
    for (int m = gw; m < M; m += NGW) {
        const float* xrow = m < MP ? F.xp + (size_t)m * D : F.xs + (size_t)(m - MP) * D;
        const f32x4* xr = (const f32x4*)xrow + F.lane;
        f32x4 v[4]; float s = 0.f;
#pragma unroll
        for (int j = 0; j < 4; ++j) { v[j] = xr[64 * j]; s += (v[j].x * v[j].x + v[j].y * v[j].y) + (v[j].z * v[j].z + v[j].w * v[j].w); }
        const float rstd = 1.0f / sqrtf(wave_sum(s) * (1.f / D) + EPS);
        unsigned long long* o8 = (unsigned long long*)(F.XN + (size_t)m * D) + F.lane;
#pragma unroll
        for (int j = 0; j < 4; ++j) o8[64 * j] = (unsigned long long)pk2(v[j].x * rstd * gv[j].x, v[j].y * rstd * gv[j].y) | ((unsigned long long)pk2(v[j].z * rstd * gv[j].z, v[j].w * rstd * gv[j].w) << 32);
    }
    { const int gt = F.vcu * 512 + F.tid; if (gt < D) { const float l0 = F.lb_logits[gt], l1 = F.lb_logits[D + gt]; F.LB[gt] = 1.0f / (1.0f + expf(l1 - l0)); } }
}

__device__ __forceinline__ void hgrn_slow_item(Frame& F, bool sample, int seq, int h) {
    LAS float* part = (LAS float*)F.lds; LAS float* red = part + 512;
    const int v = F.tid & 127, kq = F.tid >> 7;
    const int row0 = sample ? MP + seq * 4 : seq * SEQ, T = sample ? 4 : SEQ;
    float S[32];
#pragma unroll
    for (int j = 0; j < 32; ++j) S[j] = sample ? F.st_in[((size_t)(seq * 8 + h) * 128 + kq * 32 + j) * 128 + v] : 0.f;
    const float gn = F.a_gnorm[v];
    for (int t = 0; t < T; ++t) {
        bf16* hrow = F.H + (size_t)(row0 + t) * LDH;
        const float vv = bf2f(hrow[HC_VA + h * 128 + v]);
        float acc = 0.f;
#pragma unroll
        for (int j = 0; j < 32; ++j) { const int k = h * 128 + kq * 32 + j; const float q = bf2f(hrow[HC_QA + k]), f = __builtin_amdgcn_exp2f(h2f(hrow[HC_G2 + k]));
            S[j] = f * S[j] + (1.0f - f) * vv; acc += q * S[j]; }
        part[kq * 128 + v] = acc;
        __syncthreads();
        float o = 0.f;
        if (F.tid < 128) { o = (part[v] + part[128 + v]) + (part[256 + v] + part[384 + v]); const float ss = wave_sum(o * o); if (F.lane == 0) red[F.wave] = ss; }
        __syncthreads();
        if (F.tid < 128) { const float r = 1.0f / sqrtf((red[0] + red[1]) * (1.f / 128.f) + EPS);
            hrow[HC_HA + h * 128 + v] = (bf16)f2bf(o * r * gn * bf2f(hrow[HC_ZA + h * 128 + v])); }
    }
    float* so = F.out + (sample ? O_SS : O_SP) + ((size_t)(seq * 8 + h) * 128 + kq * 32) * 128 + v;
#pragma unroll
    for (int j = 0; j < 32; ++j) so[(size_t)j * 128] = S[j];
    __syncthreads();
}
__device__ __forceinline__ float bfw_lo(unsigned w) { return __uint_as_float(w << 16); }
__device__ __forceinline__ float bfw_hi(unsigned w) { return __uint_as_float(w & 0xffff0000u); }
__device__ __forceinline__ void swa_slow(Frame& F, int first, int stride) {
    for (int idx = first; idx < M * 16; idx += stride) {
        const int m = idx >> 4, head = idx & 15, kvh = head >> 3;
        bf16* qp = F.H + (size_t)m * LDH + HC_QB + head * 64;
        float q[64], o[64];
#pragma unroll
        for (int c = 0; c < 8; ++c) { const v4u w = *(const v4u*)(qp + 8 * c);
            q[8 * c + 0] = bfw_lo(w.x); q[8 * c + 1] = bfw_hi(w.x); q[8 * c + 2] = bfw_lo(w.y); q[8 * c + 3] = bfw_hi(w.y); q[8 * c + 4] = bfw_lo(w.z); q[8 * c + 5] = bfw_hi(w.z); q[8 * c + 6] = bfw_lo(w.w); q[8 * c + 7] = bfw_hi(w.w); }
#pragma unroll
        for (int d = 0; d < 64; ++d) o[d] = 0.f;
        const float slope2 = __builtin_amdgcn_exp2f(-0.5f * (float)(head + 1)) * LOG2E;
        float mx = F.b_sinks[head] * LOG2E, l = 1.0f;
        const bool sample = m >= MP;
        const int ms = m - MP, db = ms >> 2, t = sample ? (ms & 3) : (m & (SEQ - 1));
        const int nk = sample ? 128 : (t < 127 ? t + 1 : 128);
        for (int i = 0; i < nk; ++i) {
            int dist;
            if (sample && i < 127 - t) {
                const int j = t + 1 + i; dist = t + 128 - j;
                const float* kp = F.ck_in + ((size_t)(db * 128 + j) * 2 + kvh) * 64; const float* vp = F.cv_in + ((size_t)(db * 128 + j) * 2 + kvh) * 64;
                float sc = 0.f;
#pragma unroll
                for (int c = 0; c < 16; ++c) { const f32x4 w = *(const f32x4*)(kp + 4 * c); sc += (q[4 * c] * w.x + q[4 * c + 1] * w.y) + (q[4 * c + 2] * w.z + q[4 * c + 3] * w.w); }
                sc -= slope2 * (float)dist;
                const float mn = fmaxf(mx, sc), a = __builtin_amdgcn_exp2f(mx - mn), p = __builtin_amdgcn_exp2f(sc - mn);
                l = l * a + p; mx = mn;
#pragma unroll
                for (int c = 0; c < 16; ++c) { const f32x4 w = *(const f32x4*)(vp + 4 * c);
                    o[4 * c] = o[4 * c] * a + p * w.x; o[4 * c + 1] = o[4 * c + 1] * a + p * w.y; o[4 * c + 2] = o[4 * c + 2] * a + p * w.z; o[4 * c + 3] = o[4 * c + 3] * a + p * w.w; }
            } else {
                int srow; if (sample) { const int s = i - (127 - t); dist = t - s; srow = MP + db * 4 + s; } else { const int s = t - nk + 1 + i; dist = t - s; srow = m - dist; }
                const bf16* kp = F.H + (size_t)srow * LDH + HC_KB + kvh * 64; const bf16* vp = F.H + (size_t)srow * LDH + HC_VB + kvh * 64;
                float sc = 0.f;
#pragma unroll
                for (int c = 0; c < 8; ++c) { const v4u w = *(const v4u*)(kp + 8 * c);
                    sc += (q[8 * c] * bfw_lo(w.x) + q[8 * c + 1] * bfw_hi(w.x)) + (q[8 * c + 2] * bfw_lo(w.y) + q[8 * c + 3] * bfw_hi(w.y)) + (q[8 * c + 4] * bfw_lo(w.z) + q[8 * c + 5] * bfw_hi(w.z)) + (q[8 * c + 6] * bfw_lo(w.w) + q[8 * c + 7] * bfw_hi(w.w)); }
                sc -= slope2 * (float)dist;
                const float mn = fmaxf(mx, sc), a = __builtin_amdgcn_exp2f(mx - mn), p = __builtin_amdgcn_exp2f(sc - mn);
                l = l * a + p; mx = mn;
#pragma unroll
                for (int c = 0; c < 8; ++c) { const v4u w = *(const v4u*)(vp + 8 * c);
                    o[8 * c] = o[8 * c] * a + p * bfw_lo(w.x); o[8 * c + 1] = o[8 * c + 1] * a + p * bfw_hi(w.x); o[8 * c + 2] = o[8 * c + 2] * a + p * bfw_lo(w.y); o[8 * c + 3] = o[8 * c + 3] * a + p * bfw_hi(w.y);
                    o[8 * c + 4] = o[8 * c + 4] * a + p * bfw_lo(w.z); o[8 * c + 5] = o[8 * c + 5] * a + p * bfw_hi(w.z); o[8 * c + 6] = o[8 * c + 6] * a + p * bfw_lo(w.w); o[8 * c + 7] = o[8 * c + 7] * a + p * bfw_hi(w.w); }
            }
        }
        const float rl = 1.0f / l; const bf16* zp = F.H + (size_t)m * LDH + HC_ZB + head * 64;
#pragma unroll
        for (int c = 0; c < 8; ++c) { const v4u z = *(const v4u*)(zp + 8 * c); v4u w;
            w.x = pk2(o[8 * c] * rl * bfw_lo(z.x), o[8 * c + 1] * rl * bfw_hi(z.x)); w.y = pk2(o[8 * c + 2] * rl * bfw_lo(z.y), o[8 * c + 3] * rl * bfw_hi(z.y));
            w.z = pk2(o[8 * c + 4] * rl * bfw_lo(z.z), o[8 * c + 5] * rl * bfw_hi(z.z)); w.w = pk2(o[8 * c + 6] * rl * bfw_lo(z.w), o[8 * c + 7] * rl * bfw_hi(z.w));
            *(v4u*)(qp + 8 * c) = w; }
    }
}
__device__ __forceinline__ void p2_mixers_slow(Frame& F) {
    const int bx = blockIdx.x;
    if (bx < 64) hgrn_slow_item(F, false, bx >> 3, bx & 7);
    else for (int it = bx - 64; it < 1024; it += F.G - 64) hgrn_slow_item(F, true, it >> 3, it & 7);
    swa_slow(F, bx * 512 + F.tid, F.G * 512);
}

__device__ __forceinline__ void p5_final_norm(Frame& F) {
    const int gw = F.vcu * NWAVES + F.wave, NGW = F.G * NWAVES;
    f32x4 gv[4];
#pragma unroll
    for (int j = 0; j < 4; ++j) gv[j] = ((const f32x4*)F.norm_final)[F.lane + 64 * j];
    for (int m = gw; m < M; m += NGW) {
        float s = F.lane < 16 ? F.SSQ[(size_t)m * 16 + F.lane] : 0.f;
        s += __shfl_xor(s, 1); s += __shfl_xor(s, 2); s += __shfl_xor(s, 4); s += __shfl_xor(s, 8);
        s = __shfl(s, 0);
        const float rstd = 1.0f / sqrtf(s * (1.f / D) + EPS);
        const f32x4* yt = (const f32x4*)(F.H + (size_t)m * LDH + HC_QB) + F.lane; f32x4* yr = (f32x4*)(F.out + O_Y + (size_t)m * D) + F.lane;
#pragma unroll
        for (int j = 0; j < 4; ++j) { f32x4 y = yt[64 * j]; y = y * rstd * gv[j]; yr[64 * j] = y; }
    }
    { const int gt = F.vcu * 512 + F.tid, NT = F.G * 512;
      for (int i = gt; i < 128 * 128 * 32; i += NT) { const int c4 = (i & 31) * 4, rl = i >> 5, db = rl >> 7, l = rl & 127; const size_t dof = (size_t)rl * 128 + c4;
          f32x4 k, v; if (l < 124) { const size_t so = (size_t)(rl + 4) * 128 + c4; k = *(const f32x4*)(F.ck_in + so); v = *(const f32x4*)(F.cv_in + so); }
          else { const size_t so = (size_t)(db * 4 + (l - 124)) * 128 + c4; k = *(const f32x4*)(F.CKSN + so); v = *(const f32x4*)(F.CVSN + so); }
          *(f32x4*)(F.out + O_CKS + dof) = k; *(f32x4*)(F.out + O_CVS + dof) = v; }
      for (int i = gt; i < 8 * 128 * 32; i += NT) { const size_t o = (size_t)i * 4; *(f32x4*)(F.out + O_CKP + o) = *(const f32x4*)(F.CKP + o); *(f32x4*)(F.out + O_CVP + o) = *(const f32x4*)(F.CVP + o); } }
}

struct Args { const float* in[14]; float* out; unsigned char* ws; int ph_lo, ph_hi, li, pad; };
__global__ void __launch_bounds__(NWAVES * 64, 2) fwd(Args args) {
    extern __shared__ __attribute__((aligned(16))) unsigned char lds[];
    Frame F;
    F.lds = (LAS unsigned char*)lds;
    F.tid = threadIdx.x; F.lane = F.tid & 63; F.wave = __builtin_amdgcn_readfirstlane(F.tid >> 6);
    F.G = gridDim.x; { const int bx = blockIdx.x; F.vcu = (F.G % 8 == 0) ? (bx % 8) * (F.G / 8) + bx / 8 : bx; }
    F.xp = args.in[0]; F.xs = args.in[1]; F.st_in = args.in[2]; F.ck_in = args.in[3]; F.cv_in = args.in[4]; F.norm_in = args.in[5]; F.w_in = args.in[6]; F.lb_logits = args.in[7];
    F.a_gnorm = args.in[8]; F.b_sinks = args.in[9]; F.w_pa = args.in[10]; F.w_pb = args.in[11]; F.w_out = args.in[12]; F.norm_final = args.in[13];
    F.out = args.out; F.ws = args.ws; unsigned char* ws = args.ws;
    F.Win_t = (bf16*)(ws + WS_WIN); F.Wpa_t = (bf16*)(ws + WS_WPA); F.Wpb_t = (bf16*)(ws + WS_WPB); F.Wout_t = (bf16*)(ws + WS_WOUT);
    F.XN = (bf16*)(ws + WS_XN); F.H = (bf16*)(ws + WS_H); F.LB = (float*)(ws + WS_LB); F.SSQ = (float*)(ws + WS_SSQ);
    F.CKP = (float*)(ws + WS_CKP); F.CVP = (float*)(ws + WS_CVP); F.CKSN = (float*)(ws + WS_CKSN); F.CVSN = (float*)(ws + WS_CVSN);
    volatile LAS unsigned* MISC = (volatile LAS unsigned*)(F.lds + MISC_OFF);
    for (int u = F.tid; u < (LDS_BYTES - LDSCTL_OFF) / 4; u += NWAVES * 64) ((LAS unsigned*)(F.lds + LDSCTL_OFF))[u] = 0u;
    __syncthreads();
    XcdBarrier bar; bar.bar = (unsigned*)(ws + WS_CTL) + CW_BAR; bar.x = 0; bar.st = nullptr;
    if (N_LAUNCHES == 1) bar = xcd_barrier_post((unsigned*)(ws + WS_CTL) + CW_BAR, MISC + 8);
    const int lo = args.ph_lo, hi = args.ph_hi;
#define IN(k) (lo <= (k) && (k) < hi)
#define SEAM(k) do { if (IN(k) && IN((k) + 1)) xcd_barrier(bar); } while (0)

    if (IN(0)) { p0_prologue(F); SEAM(0); }
    if (IN(1)) {
        pg8::Gemm g{F.XN, F.XN, F.Win_t, F.Win_t, D, D, D}; pg8::StaticOrder S; S.init(M, NMIX, F.G, (int)blockIdx.x, 0);
        pg8::EpiIn E{F.H, F.LB, F.CKP, F.CVP, F.CKSN, F.CVSN, 0};
        pg8::gemm_phase<pg8::EpiIn, pg8::StaticOrder>(F.lds, g, S, E);
        SEAM(1);
    }
    if (IN(2)) { p2_mixers_slow(F); SEAM(2); }
    if (IN(3)) { SEAM(3); }
    if (IN(4)) {
        pg8::Gemm g{F.XN, F.XN, F.Win_t + (size_t)NMIX * D, F.Win_t + (size_t)NMIX * D, D, D, D}; pg8::StaticOrder S; S.init(M, 2048, F.G, (int)blockIdx.x, 0);
        pg8::EpiIn E{F.H, F.LB, F.CKP, F.CVP, F.CKSN, F.CVSN, 1};
        pg8::gemm_phase<pg8::EpiIn, pg8::StaticOrder>(F.lds, g, S, E);
        SEAM(4);
    }
    if (IN(5)) {
        pg8::Gemm g{F.H + HC_HA, F.H + HC_HB, F.Wpa_t, F.Wpb_t, LDH, D, D}; pg8::StaticOrder S; S.init(M, D, F.G, (int)blockIdx.x, 1);
        pg8::EpiMerge E{F.H, F.H + HC_MG};
        pg8::gemm_phase<pg8::EpiMerge, pg8::StaticOrder>(F.lds, g, S, E);
        SEAM(5);
    }
    if (IN(6)) {
        pg8::Gemm g{F.H + HC_MG, F.H + HC_MG, F.Wout_t, F.Wout_t, LDH, D, D}; pg8::StaticOrder S; S.init(M, D, F.G, (int)blockIdx.x, 0);
        pg8::EpiOut E{F.xp, F.xs, F.H + HC_QB, F.SSQ};
        pg8::gemm_phase<pg8::EpiOut, pg8::StaticOrder>(F.lds, g, S, E);
        SEAM(6);
    }
    if (IN(7)) { p5_final_norm(F); }
#undef IN
#undef SEAM
}

extern "C" void kernel_launch(void* const* d_in, const int* in_sizes, int n_in, void* d_out, int out_size, void* d_ws, size_t ws_size, hipStream_t stream) {
    static int grid = 0;
    if (grid == 0) {
        if (n_in != 14 || (size_t)out_size != O_END || ws_size < WS_END) { fprintf(stderr, "kernel_launch: unexpected shapes: n_in %d out %d ws %zu (need %zu)\n", n_in, out_size, ws_size, (size_t)WS_END); grid = -1; return; }
        int dev = 0, cus = 0;
        if (hipGetDevice(&dev) != hipSuccess || hipDeviceGetAttribute(&cus, hipDeviceAttributeMultiprocessorCount, dev) != hipSuccess) { grid = -1; return; }
        if (hipFuncSetAttribute((const void*)fwd, hipFuncAttributeMaxDynamicSharedMemorySize, LDS_BYTES) != hipSuccess) { fprintf(stderr, "kernel_launch: hipFuncSetAttribute failed\n"); grid = -1; return; }
        int per_cu = 0;
        (void)hipOccupancyMaxActiveBlocksPerMultiprocessor(&per_cu, (const void*)fwd, NWAVES * 64, LDS_BYTES);
        (void)hipGetLastError();
        grid = cus;
    }
    if (grid < 0) return;
    (void)hipMemsetAsync((char*)d_ws + WS_CTL, 0, CTL_ZERO_BYTES, stream);
    Args a{};
    for (int i = 0; i < 14; ++i) a.in[i] = (const float*)d_in[i];
    a.out = (float*)d_out; a.ws = (unsigned char*)d_ws;
    for (int li = 0; li < N_LAUNCHES; ++li) {
        a.ph_lo = (N_LAUNCHES == 1) ? 0 : li; a.ph_hi = (N_LAUNCHES == 1) ? NPHASE : li + 1; a.li = li;
        hipLaunchKernelGGL(fwd, dim3(grid), dim3(NWAVES * 64), LDS_BYTES, stream, a);
    }
}
```

```cpp
#include <hip/hip_runtime.h>
#include <cstdio>
#include <cstdint>

#ifndef MK_N_LAUNCHES
#define MK_N_LAUNCHES 1
#endif

constexpr int D = 1024, MP = 32768, MS = 512, M = MP + MS, SEQ = 4096, NIN = 8448;
constexpr int LDH = 6400;
constexpr int HC_QA = 0, HC_G2 = 1024, HC_VA = 2048, HC_ZA = 3072, HC_QB = 4096, HC_KB = 5120, HC_VB = 5248, HC_ZB = 5376;
constexpr int HC_HA = HC_VA, HC_HB = HC_QB, HC_GA = 0, HC_GB = 1024, HC_MG = HC_ZA;
constexpr int NMIX = 6400;
constexpr float EPS = 1e-6f, LOG2E = 1.4426950408889634f, C2 = 0.125f * 1.4426950408889634f;
constexpr size_t O_Y = 0, O_SP = 34078720, O_CKP = 35127296, O_CVP = 35258368, O_SS = 35389440, O_CKS = 52166656, O_CVS = 54263808, O_END = 56360960;
constexpr size_t MiB = 1u << 20;
constexpr size_t WS_CTL = 0, CTL_ZERO_BYTES = 1 * MiB;
constexpr size_t WS_LB = 1 * MiB;
constexpr size_t WS_CKP = 1 * MiB + 65536, WS_CVP = WS_CKP + 524288, WS_CKSN = WS_CVP + 524288, WS_CVSN = WS_CKSN + 262144;
constexpr size_t WS_WIN = 3 * MiB;
constexpr size_t WS_WPA = 20 * MiB, WS_WPB = 22 * MiB, WS_WOUT = 24 * MiB;
constexpr size_t WS_XN = 26 * MiB;
constexpr size_t WS_SSQ = 26 * MiB;
constexpr size_t WS_H = 91 * MiB;
constexpr size_t WS_END = WS_H + (size_t)M * LDH * 2;
constexpr size_t WS_HU = 498 * MiB, WS_HD = 510 * MiB;
static_assert(WS_CVSN + 262144 <= WS_WIN && WS_XN + (size_t)M * D * 2 <= WS_H && WS_END <= WS_HU && WS_HU + 12 * MiB <= WS_HD && WS_HD + MiB <= 512 * MiB, "ws map");

namespace pg8 {
#define PG8_LAS __attribute__((address_space(3)))
typedef unsigned short bf16_t;
typedef short bf16x8 __attribute__((ext_vector_type(8)));
typedef float f32x4 __attribute__((ext_vector_type(4)));
typedef unsigned u32x4 __attribute__((ext_vector_type(4)));
constexpr int BM = 256, BK = 64, HALF = 128, HTB = HALF * BK * 2, STAGE_BYTES = 8 * HTB, NXCD = 8, WGM = 8;

__host__ __device__ __forceinline__ int lds_byte(int r, int c) { const int st = (r >> 4) * 2 + (c >> 5), rr = r & 15, cc = c & 31, ob = rr * 64 + cc * 2; return st * 1024 + (ob ^ (((ob >> 9) & 1) << 5)); }
__host__ __device__ __forceinline__ void stage_rc(int b, int& R, int& C) { const int st = b / 1024, sb = b % 1024, swz = sb ^ (((sb >> 9) & 1) << 5); R = (st >> 1) * 16 + swz / 64; C = (st & 1) * 32 + (swz % 64) / 2; }
__host__ __device__ __forceinline__ int perm32(int rho) { const int n = rho >> 4, i = rho & 15; return 8 * (i >> 2) + 4 * n + (i & 3); }

struct Unit { int pm, pn, sub; };
struct Gemm { const bf16_t *A0, *A1, *B0, *B1; int lda, ldb, K; };

struct StaticOrder {
    int nM, nN, nwg, G, c, dbl;
    __host__ __device__ void init(int M_, int N_, int G_, int c_, int dbl_) { nM = M_ / BM; nN = N_ / BM; nwg = nM * nN; G = G_; c = c_; dbl = dbl_; }
    __host__ __device__ bool next(int i, Unit& u) const {
        const int it = dbl ? (i >> 1) : i; u.sub = dbl ? (i & 1) : 0;
        const long L = (long)it * G + c; if (L >= nwg) return false;
        int wgid = (int)L; { const int q = nwg / NXCD, r = nwg % NXCD, xcd = wgid % NXCD, off = wgid / NXCD; wgid = (xcd < r ? xcd * (q + 1) : r * (q + 1) + (xcd - r) * q) + off; }
        const int nig = WGM * nN, gid = wgid / nig, fm = gid * WGM, gsz = (nM - fm) < WGM ? (nM - fm) : WGM;
        u.pm = fm + ((wgid % nig) % gsz); u.pn = (wgid % nig) / gsz; return true;
    }
};

typedef float f32x2_t __attribute__((ext_vector_type(2))); typedef __bf16 bf16x2_t __attribute__((ext_vector_type(2)));
__device__ __forceinline__ unsigned cvt_pk_bf16(float lo, float hi) { f32x2_t v = {lo, hi}; bf16x2_t b = __builtin_convertvector(v, bf16x2_t); return __builtin_bit_cast(unsigned, b); }
__device__ __forceinline__ float bf_lo(unsigned w) { return __uint_as_float(w << 16); }
__device__ __forceinline__ float bf_hi(unsigned w) { return __uint_as_float(w & 0xffff0000u); }

typedef f32x4 Acc[2][2][4][2];

template <class Epi, class Sched>
__device__ __forceinline__ void gemm_phase(PG8_LAS unsigned char* lds, const Gemm g, const Sched& S, const Epi& E) {
    const int tid = threadIdx.x, wid = __builtin_amdgcn_readfirstlane(tid >> 6), lane = tid & 63, wr = wid >> 2, wc = wid & 3, fr = lane & 15, fq = lane >> 4;
    const int K = g.K, nt = K / BK;
    unsigned voffA[2], voffB[2];
#pragma unroll
    for (int i = 0; i < 2; ++i) { int R, C; stage_rc(tid * 16 + i * 8192, R, C); const int Rb = Epi::PERM ? ((R & ~31) + perm32(R & 31)) : R;
        voffA[i] = (unsigned)(R * g.lda + C) * 2u; voffB[i] = (unsigned)(Rb * g.ldb + C) * 2u; }
    const size_t kstep = (size_t)(BK * 2);
    const size_t hstepA = (size_t)HALF * g.lda * 2, hstepB = (size_t)HALF * g.ldb * 2;
    const size_t tstepA = 2 * hstepA, tstepB = 2 * hstepB;
    const unsigned ldsw = (unsigned)wid * 1024u;
    const int aoff = lds_byte(wr * 64 + fr, fq * 8), boff = lds_byte(wc * 32 + fr, fq * 8);
#define PG8_SA(b, h) (((b) * 2 + (h)) * HTB)
#define PG8_SB(b, h) ((4 + (b) * 2 + (h)) * HTB)
#define PG8_STAGE(bufoff, gbase, voff) do { _Pragma("unroll") for (int _i = 0; _i < 2; ++_i) \
        __builtin_amdgcn_global_load_lds((const unsigned*)((const char*)(gbase) + (voff)[_i]), (PG8_LAS unsigned*)(lds + (bufoff) + ldsw + _i * 8192), 16, 0, 0); } while (0)
#define PG8_LDA(dst, b, h) do { _Pragma("unroll") for (int m = 0; m < 4; ++m) _Pragma("unroll") for (int k = 0; k < 2; ++k) dst[m][k] = *(const PG8_LAS bf16x8*)(lds + PG8_SA(b, h) + aoff + m * 2048 + k * 1024); } while (0)
#define PG8_LDB(dst, b, h) do { _Pragma("unroll") for (int n = 0; n < 2; ++n) _Pragma("unroll") for (int k = 0; k < 2; ++k) dst[n][k] = *(const PG8_LAS bf16x8*)(lds + PG8_SB(b, h) + boff + n * 2048 + k * 1024); } while (0)
#define PG8_MMA(ai, bj, At, Bt) do { __builtin_amdgcn_s_setprio(1); _Pragma("unroll") for (int m = 0; m < 4; ++m) _Pragma("unroll") for (int n = 0; n < 2; ++n) _Pragma("unroll") for (int k = 0; k < 2; ++k) \
        acc[ai][bj][m][n] = __builtin_amdgcn_mfma_f32_16x16x32_bf16(Bt[n][k], At[m][k], acc[ai][bj][m][n], 0, 0, 0); __builtin_amdgcn_s_setprio(0); } while (0)
#define PG8_WAIT_V(n) asm volatile("s_waitcnt vmcnt(" #n ")" ::: "memory")
#define PG8_WAIT_L(n) asm volatile("s_waitcnt lgkmcnt(" #n ")" ::: "memory")
#define PG8_BAR __builtin_amdgcn_s_barrier()
#define PG8_SCHED __builtin_amdgcn_sched_barrier(0)
    Unit cur, nxt; int ui = 0;
    if (!S.next(0, cur)) return;
    Acc acc;
#pragma unroll
    for (int a = 0; a < 2; ++a)
#pragma unroll
        for (int b = 0; b < 2; ++b)
#pragma unroll
            for (int m = 0; m < 4; ++m)
#pragma unroll
                for (int n = 0; n < 2; ++n) acc[a][b][m][n] = (f32x4){0.f, 0.f, 0.f, 0.f};
    bf16x8 At[4][2], B0[2][2], B1[2][2];
    const char* cA = (const char*)(cur.sub ? g.A1 : g.A0) + (size_t)cur.pm * tstepA; const char* cB = (const char*)(cur.sub ? g.B1 : g.B0) + (size_t)cur.pn * tstepB;
    PG8_STAGE(PG8_SB(0, 0), cB, voffB); PG8_STAGE(PG8_SB(0, 1), cB + hstepB, voffB); PG8_STAGE(PG8_SA(0, 0), cA, voffA); PG8_STAGE(PG8_SA(0, 1), cA + hstepA, voffA);
    if (wr == 1) PG8_BAR;
    PG8_WAIT_V(2); PG8_BAR;
    PG8_STAGE(PG8_SB(1, 0), cB + kstep, voffB); PG8_STAGE(PG8_SA(1, 0), cA + kstep, voffA); PG8_STAGE(PG8_SB(1, 1), cB + hstepB + kstep, voffB);
    PG8_WAIT_V(6); PG8_BAR;
    for (;;) {
        const bool has_next = S.next(ui + 1, nxt);
        const char* nA = has_next ? (const char*)(nxt.sub ? g.A1 : g.A0) + (size_t)nxt.pm * tstepA : cA; const char* nB = has_next ? (const char*)(nxt.sub ? g.B1 : g.B0) + (size_t)nxt.pn * tstepB : cB;
        for (int t = 0; t < nt; t += 2) {
            const bool last = (t == nt - 2);
            const char* a1 = cA + (size_t)(t + 1) * kstep;
            const char* a2 = last ? nA : cA + (size_t)(t + 2) * kstep; const char* b2 = last ? nB : cB + (size_t)(t + 2) * kstep;
            const char* a3 = a2 + kstep; const char* b3 = b2 + kstep;
            PG8_LDB(B0, 0, 0); PG8_LDB(B1, 0, 1); PG8_SCHED; PG8_LDA(At, 0, 0); PG8_STAGE(PG8_SA(1, 1), a1 + hstepA, voffA);
            PG8_WAIT_V(8); PG8_WAIT_L(0); PG8_BAR; PG8_MMA(0, 0, At, B0); PG8_MMA(0, 1, At, B1); PG8_BAR; PG8_SCHED;
            PG8_LDA(At, 0, 1); PG8_STAGE(PG8_SB(0, 0), b2, voffB); PG8_STAGE(PG8_SB(0, 1), b2 + hstepB, voffB); PG8_STAGE(PG8_SA(0, 0), a2, voffA);
            PG8_WAIT_V(8); PG8_WAIT_L(0); PG8_BAR; PG8_MMA(1, 0, At, B0); PG8_MMA(1, 1, At, B1); PG8_BAR; PG8_SCHED;
            PG8_LDB(B0, 1, 0); PG8_LDB(B1, 1, 1); PG8_SCHED; PG8_LDA(At, 1, 0); PG8_STAGE(PG8_SA(0, 1), a2 + hstepA, voffA);
            PG8_WAIT_V(8); PG8_WAIT_L(0); PG8_BAR; PG8_MMA(0, 0, At, B0); PG8_MMA(0, 1, At, B1); PG8_BAR; PG8_SCHED;
            PG8_LDA(At, 1, 1); PG8_STAGE(PG8_SB(1, 0), b3, voffB); PG8_STAGE(PG8_SB(1, 1), b3 + hstepB, voffB); PG8_STAGE(PG8_SA(1, 0), a3, voffA);
            PG8_WAIT_V(8); PG8_WAIT_L(0); PG8_BAR; PG8_MMA(1, 0, At, B0); PG8_MMA(1, 1, At, B1); PG8_BAR; PG8_SCHED;
        }
        if (wr == 0) PG8_BAR;
        const bool keep = E(acc, cur, wr, wc, fr, fq);
        if (!has_next) break;
        if (!keep) {
#pragma unroll
        for (int a = 0; a < 2; ++a)
#pragma unroll
            for (int b = 0; b < 2; ++b)
#pragma unroll
                for (int m = 0; m < 4; ++m)
#pragma unroll
                    for (int n = 0; n < 2; ++n) acc[a][b][m][n] = (f32x4){0.f, 0.f, 0.f, 0.f};
        }
        cur = nxt; cA = nA; cB = nB; ++ui;
        if (wr == 1) PG8_BAR;
    }
    PG8_WAIT_V(0);
    PG8_BAR;
#undef PG8_SA
#undef PG8_SB
#undef PG8_STAGE
#undef PG8_LDA
#undef PG8_LDB
#undef PG8_MMA
#undef PG8_WAIT_V
#undef PG8_WAIT_L
#undef PG8_BAR
#undef PG8_SCHED
}

__device__ __forceinline__ float sigmoidf_(float x) { return __builtin_amdgcn_rcpf(1.0f + __builtin_amdgcn_exp2f(-x * LOG2E)); }
__device__ __forceinline__ float siluf_(float x) { return x * sigmoidf_(x); }
__device__ __forceinline__ unsigned cvt_pk_f16(float lo, float hi) { typedef _Float16 h2 __attribute__((ext_vector_type(2))); h2 v; v.x = (_Float16)lo; v.y = (_Float16)hi; return __builtin_bit_cast(unsigned, v); }

struct EpiIn {
    static constexpr bool PERM = true;
    bf16_t* H; const float* lb; float *ckp, *cvp, *cksn, *cvsn; int gate;
    template <int MODE> __device__ __forceinline__ void run(Acc& acc, const Unit& u, int wr, int wc, int fr, int fq) const {
        const int row0 = u.pm * BM + wr * 64 + fr, cb = wc * 32 + 8 * fq;
        bf16_t* base; int ld;
        base = H + u.pn * 256 + cb; ld = LDH;
        float lbv[2][8];
        if (MODE == 2) {
#pragma unroll
            for (int bj = 0; bj < 2; ++bj) { const f32x4 a = *(const f32x4*)(lb + (u.pn - 4) * 256 + bj * HALF + cb), b = *(const f32x4*)(lb + (u.pn - 4) * 256 + bj * HALF + cb + 4);
                lbv[bj][0] = a[0]; lbv[bj][1] = a[1]; lbv[bj][2] = a[2]; lbv[bj][3] = a[3]; lbv[bj][4] = b[0]; lbv[bj][5] = b[1]; lbv[bj][6] = b[2]; lbv[bj][7] = b[3]; }
        }
#pragma unroll
        for (int ai = 0; ai < 2; ++ai)
#pragma unroll
            for (int m = 0; m < 4; ++m) { const int row = row0 + ai * HALF + m * 16; bf16_t* rowp = base + (size_t)row * ld;
#pragma unroll
                for (int bj = 0; bj < 2; ++bj) { float v[8];
#pragma unroll
                    for (int j = 0; j < 4; ++j) { v[j] = acc[ai][bj][m][0][j]; v[4 + j] = acc[ai][bj][m][1][j]; }
                    if (MODE == 5) {
                        float* dst = nullptr;
                        if (row < MP) { const int t = row & (SEQ - 1); if (t >= SEQ - 128) dst = (bj ? cvp : ckp) + ((size_t)((row >> 12) * 128 + (t - (SEQ - 128))) * 128 + cb); }
                        else { const int ms = row - MP; dst = (bj ? cvsn : cksn) + ((size_t)ms * 128 + cb); }
                        if (dst) { *(f32x4*)dst = acc[ai][bj][m][0]; *(f32x4*)(dst + 4) = acc[ai][bj][m][1]; }
                    }
                    u32x4 w;
                    if (MODE == 2) {
#pragma unroll
                        for (int j = 0; j < 8; ++j) { const float l = lbv[bj][j]; v[j] = __builtin_amdgcn_logf(l + (1.0f - l) * sigmoidf_(v[j])); }
                        w.x = cvt_pk_f16(v[0], v[1]); w.y = cvt_pk_f16(v[2], v[3]); w.z = cvt_pk_f16(v[4], v[5]); w.w = cvt_pk_f16(v[6], v[7]);
                    } else {
#pragma unroll
                        for (int j = 0; j < 8; ++j) { if (MODE == 1) v[j] = siluf_(v[j]); if (MODE == 3) v[j] *= C2; if (MODE == 4) v[j] = sigmoidf_(v[j]); }
                        w.x = cvt_pk_bf16(v[0], v[1]); w.y = cvt_pk_bf16(v[2], v[3]); w.z = cvt_pk_bf16(v[4], v[5]); w.w = cvt_pk_bf16(v[6], v[7]);
                    }
                    *(u32x4*)(rowp + bj * HALF) = w; } }
    }
    __device__ __forceinline__ bool operator()(Acc& acc, const Unit& u, int wr, int wc, int fr, int fq) const {
        const int pn = u.pn;
        if (gate) { run<4>(acc, u, wr, wc, fr, fq); return false; }
        if (pn < 4) run<1>(acc, u, wr, wc, fr, fq);
        else if (pn < 8) run<2>(acc, u, wr, wc, fr, fq);
        else if (pn < 12) run<0>(acc, u, wr, wc, fr, fq);
        else if (pn < 16) run<1>(acc, u, wr, wc, fr, fq);
        else if (pn < 20) run<3>(acc, u, wr, wc, fr, fq);
        else if (pn == 20) run<5>(acc, u, wr, wc, fr, fq);
        else run<1>(acc, u, wr, wc, fr, fq);
        return false;
    }
};

struct EpiMerge {
    static constexpr bool PERM = true;
    const bf16_t* HG; bf16_t* MG;
    __device__ __forceinline__ bool operator()(Acc& acc, const Unit& u, int wr, int wc, int fr, int fq) const {
        const int row0 = u.pm * BM + wr * 64 + fr, col0 = u.pn * BM + wc * 32 + 8 * fq;
#pragma unroll
        for (int ai = 0; ai < 2; ++ai)
#pragma unroll
            for (int m = 0; m < 4; ++m) { const int row = row0 + ai * HALF + m * 16; const bf16_t* gp = HG + (size_t)row * LDH + col0;
#pragma unroll
                for (int bj = 0; bj < 2; ++bj) {
                    const u32x4 gb = *(const u32x4*)(gp + 1024 + bj * HALF);
                    float b[8] = {bf_lo(gb.x), bf_hi(gb.x), bf_lo(gb.y), bf_hi(gb.y), bf_lo(gb.z), bf_hi(gb.z), bf_lo(gb.w), bf_hi(gb.w)};
                    if (u.sub == 0) {
                        const u32x4 ga = *(const u32x4*)(gp + bj * HALF);
                        float a[8] = {bf_lo(ga.x), bf_hi(ga.x), bf_lo(ga.y), bf_hi(ga.y), bf_lo(ga.z), bf_hi(ga.z), bf_lo(ga.w), bf_hi(ga.w)};
#pragma unroll
                        for (int j = 0; j < 4; ++j) { acc[ai][bj][m][0][j] *= a[j] * __builtin_amdgcn_rcpf(b[j]); acc[ai][bj][m][1][j] *= a[4 + j] * __builtin_amdgcn_rcpf(b[4 + j]); }
                    } else {
                        float v[8];
#pragma unroll
                        for (int j = 0; j < 4; ++j) { v[j] = acc[ai][bj][m][0][j] * b[j]; v[4 + j] = acc[ai][bj][m][1][j] * b[4 + j]; }
                        u32x4 w; w.x = cvt_pk_bf16(v[0], v[1]); w.y = cvt_pk_bf16(v[2], v[3]); w.z = cvt_pk_bf16(v[4], v[5]); w.w = cvt_pk_bf16(v[6], v[7]);
                        *(u32x4*)(MG + (size_t)row * LDH + col0 + bj * HALF) = w;
                    } } }
        return u.sub == 0;
    }
};

struct EpiOut {
    static constexpr bool PERM = false;
    const float* xp; const float* xs; bf16_t* YT; float* SSQ;
    __device__ __forceinline__ bool operator()(Acc& acc, const Unit& u, int wr, int wc, int fr, int fq) const {
        const int row0 = u.pm * BM + wr * 64 + fr, col0 = u.pn * BM + wc * 32 + 4 * fq;
#pragma unroll
        for (int ai = 0; ai < 2; ++ai)
#pragma unroll
            for (int m = 0; m < 4; ++m) { const int row = row0 + ai * HALF + m * 16;
                const float* xr = (row < MP ? xp + (size_t)row * D : xs + (size_t)(row - MP) * D) + col0; float* yr = (float*)(YT + (size_t)row * LDH) + col0; float ss = 0.f;
#pragma unroll
                for (int bj = 0; bj < 2; ++bj)
#pragma unroll
                    for (int n = 0; n < 2; ++n) { const f32x4 y = *(const f32x4*)(xr + bj * HALF + n * 16) + acc[ai][bj][m][n]; *(f32x4*)(yr + bj * HALF + n * 16) = y;
                        ss += (y[0] * y[0] + y[1] * y[1]) + (y[2] * y[2] + y[3] * y[3]); }
                ss += __shfl_xor(ss, 16); ss += __shfl_xor(ss, 32);
                if (fq == 0) SSQ[(size_t)row * 16 + u.pn * 4 + wc] = ss; }
        return false;
    }
};
}

constexpr int NWAVES = 8;
constexpr int N_LAUNCHES = MK_N_LAUNCHES;
constexpr int NPHASE = 8;
constexpr int RING_BYTES = 131072, LDSCTL_OFF = RING_BYTES, MISC_OFF = LDSCTL_OFF + 320, LDS_BYTES = 147456;
constexpr int CW_BAR = 4096;

#define GAS __attribute__((address_space(1)))
#define LAS __attribute__((address_space(3)))
typedef unsigned short bf16;
typedef unsigned v4u __attribute__((ext_vector_type(4)));
typedef float f32x4 __attribute__((ext_vector_type(4)));
typedef GAS unsigned gu32;
#define RLX_AGENT __ATOMIC_RELAXED, __HIP_MEMORY_SCOPE_AGENT
#define LDS_WAIT() asm volatile("s_waitcnt lgkmcnt(0)" ::: "memory")
__device__ __forceinline__ unsigned f2bf(float f) { unsigned u = __builtin_bit_cast(unsigned, f); return (u + 0x7fffu + ((u >> 16) & 1u)) >> 16; }
__device__ __forceinline__ unsigned pk2(float lo, float hi) { return f2bf(lo) | (f2bf(hi) << 16); }
__device__ __forceinline__ float bf2f(bf16 h) { return __uint_as_float((unsigned)h << 16); }
__device__ __forceinline__ float h2f(bf16 h) { return (float)__builtin_bit_cast(_Float16, h); }

#define XB_TMO      128
#define XB_XCNT(j)  (256  + 64 * (j))
#define XB_XSUB(j)  (1280 + 64 * (j))
#define XB_XGEN(j)  (2304 + 64 * (j))
#define XB_TOP      3328
#define XB_TOPGEN   3392
#define XCD_BAR_WORDS 3456
#define XB_SPIN_CAP (1u << 22)
__device__ __forceinline__ unsigned xb_ld(unsigned* p)              { return __hip_atomic_load(p, __ATOMIC_RELAXED, __HIP_MEMORY_SCOPE_AGENT); }
__device__ __forceinline__ unsigned xb_add(unsigned* p, unsigned v) { return __hip_atomic_fetch_add(p, v, __ATOMIC_RELAXED, __HIP_MEMORY_SCOPE_AGENT); }
__device__ __forceinline__ unsigned xb_xcc_id() { return (unsigned)__builtin_amdgcn_s_getreg((3 << 11) | 20) & 0xFu; }
#define XB_SPIN(cond, bar) do { unsigned _sp = 0; while (cond) { __builtin_amdgcn_s_sleep(1); \
    if ((++_sp & 255u) == 0u) { if (xb_ld(&(bar)[XB_TMO])) break; if (_sp > XB_SPIN_CAP) { atomicAdd(&(bar)[XB_TMO], 1u); break; } } } } while (0)
struct XcdBarrier { unsigned* bar; unsigned x; volatile LAS unsigned* st; };
__device__ __forceinline__ XcdBarrier xcd_barrier_post(unsigned* bar, volatile LAS unsigned* st) {
    XcdBarrier b; b.bar = bar; b.x = xb_xcc_id(); b.st = st;
    if (threadIdx.x == 0) (void)xb_add(&bar[XB_XCNT(b.x)], 1u);
    return b;
}
__device__ __forceinline__ void xcd_barrier_complete(unsigned* bar, unsigned x, unsigned& nloc, unsigned& nx) {
    const unsigned G = gridDim.x * gridDim.y * gridDim.z;
    unsigned sum, cnt, mine, sp = 0u;
    for (;;) {
        sum = 0u; cnt = 0u; mine = 0u;
#pragma unroll
        for (unsigned j = 0; j < 16; ++j) { const unsigned c = xb_ld(&bar[XB_XCNT(j)]); sum += c; cnt += (c > 0u) ? 1u : 0u; mine = (j == x) ? c : mine; }
        if (sum == G) break;
        __builtin_amdgcn_s_sleep(1);
        if ((++sp & 255u) == 0u) { if (xb_ld(&bar[XB_TMO])) break; if (sp > XB_SPIN_CAP) { atomicAdd(&bar[XB_TMO], 1u); break; } }
    }
    nloc = mine > 0u ? mine : 1u; nx = cnt > 0u ? cnt : 1u;
}
__device__ __forceinline__ void xcd_barrier(const XcdBarrier& b) {
    asm volatile("s_waitcnt vmcnt(0)" ::: "memory");
    __syncthreads();
    if (threadIdx.x == 0) {
        unsigned* bar = b.bar;
        __builtin_amdgcn_s_waitcnt(0);
        unsigned nloc = b.st[0], nx = b.st[1];
        if (nloc == 0u) { xcd_barrier_complete(bar, b.x, nloc, nx); b.st[0] = nloc; b.st[1] = nx; }
        const unsigned old = xb_add(&bar[XB_XSUB(b.x)], 1u);
        const unsigned gen = old / nloc;
        if (old + 1u == (gen + 1u) * nloc) {
            __builtin_amdgcn_fence(__ATOMIC_RELEASE, "agent");
            asm volatile("s_waitcnt vmcnt(0)" ::: "memory");
            const unsigned og = xb_add(&bar[XB_TOP], 1u);
            const unsigned tg = og / nx;
            if (og + 1u == (tg + 1u) * nx) xb_add(&bar[XB_TOPGEN], 1u);
            else XB_SPIN(xb_ld(&bar[XB_TOPGEN]) == tg, bar);
            __builtin_amdgcn_fence(__ATOMIC_ACQUIRE, "agent");
            xb_add(&bar[XB_XGEN(b.x)], 1u);
            asm volatile("s_waitcnt vmcnt(0)" ::: "memory");
        } else {
            XB_SPIN(xb_ld(&bar[XB_XGEN(b.x)]) == gen, bar);
            __builtin_amdgcn_fence(__ATOMIC_ACQUIRE, "agent");
            asm volatile("s_waitcnt vmcnt(0)" ::: "memory");
        }
    }
    __syncthreads();
}

struct Frame {
    LAS unsigned char* lds;
    int tid, lane, wave, vcu, G;
    const float *xp, *xs, *st_in, *ck_in, *cv_in, *norm_in, *w_in, *lb_logits, *a_gnorm, *b_sinks, *w_pa, *w_pb, *w_out, *norm_final;
    float* out; unsigned char* ws;
    bf16 *Win_t, *Wpa_t, *Wpb_t, *Wout_t, *XN, *H; float *LB, *SSQ, *CKP, *CVP, *CKSN, *CVSN;
};

__device__ __forceinline__ float wave_sum(float v) {
#pragma unroll
    for (int o = 1; o < 64; o <<= 1) v += __shfl_xor(v, o);
    return v;
}

__device__ __forceinline__ void p0_transpose_item(const float* W, int K, int N, bf16* WT, LAS float* scr, int item, int lane) {
    const int nblk = N / 32, kb = item / nblk, nb = item % nblk, k0 = 64 * kb, n0 = 32 * nb;
#pragma unroll 8
    for (int i = 0; i < 32; ++i) { const int kk = 2 * i + (lane >> 5); scr[kk * 33 + (lane & 31)] = W[(size_t)(k0 + kk) * N + n0 + (lane & 31)]; }
    LDS_WAIT(); asm volatile("" ::: "memory");
    const int c = lane & 7;
#pragma unroll
    for (int j = 0; j < 4; ++j) { const int n = (lane >> 3) + 8 * j; const LAS float* s = scr + (8 * c) * 33 + n;
        v4u o; o.x = pk2(s[0 * 33], s[1 * 33]); o.y = pk2(s[2 * 33], s[3 * 33]); o.z = pk2(s[4 * 33], s[5 * 33]); o.w = pk2(s[6 * 33], s[7 * 33]);
        *(GAS v4u*)(WT + (size_t)(n0 + n) * K + k0 + 8 * c) = o; }
    LDS_WAIT(); asm volatile("" ::: "memory");
}
__device__ __forceinline__ void p0_prologue(Frame& F) {
    LAS float* scr = (LAS float*)(F.lds + F.wave * 16384);
    const int gw = F.vcu * NWAVES + F.wave, NGW = F.G * NWAVES;
    constexpr int I_IN = (D / 64) * (NIN / 32), I_SQ = (D / 64) * (D / 32);
    constexpr int NITEMS = I_IN + 3 * I_SQ;
    for (int it = gw; it < NITEMS; it += NGW) {
        int r = it;
        if (r < I_IN) { p0_transpose_item(F.w_in, D, NIN, F.Win_t, scr, r, F.lane); continue; } r -= I_IN;
        if (r < I_SQ) { p0_transpose_item(F.w_pa, D, D, F.Wpa_t, scr, r, F.lane); continue; } r -= I_SQ;
        if (r < I_SQ) { p0_transpose_item(F.w_pb, D, D, F.Wpb_t, scr, r, F.lane); continue; } r -= I_SQ;
        p0_transpose_item(F.w_out, D, D, F.Wout_t, scr, r, F.lane);
    }
    f32x4 gv[4];
#pragma unroll
    for (int j = 0; j < 4; ++j) gv[j] = ((const f32x4*)F.norm_in)[F.lane + 64 * j];
    for (int m = gw; m < M; m += NGW) {
        const float* xrow = m < MP ? F.xp + (size_t)m * D : F.xs + (size_t)(m - MP) * D;
        const f32x4* xr = (const f32x4*)xrow + F.lane;
        f32x4 v[4]; float s = 0.f;
#pragma unroll
        for (int j = 0; j < 4; ++j) { v[j] = xr[64 * j]; s += (v[j].x * v[j].x + v[j].y * v[j].y) + (v[j].z * v[j].z + v[j].w * v[j].w); }
        const float rstd = 1.0f / sqrtf(wave_sum(s) * (1.f / D) + EPS);
        unsigned long long* o8 = (unsigned long long*)(F.XN + (size_t)m * D) + F.lane;
#pragma unroll
        for (int j = 0; j < 4; ++j) o8[64 * j] = (unsigned long long)pk2(v[j].x * rstd * gv[j].x, v[j].y * rstd * gv[j].y) | ((unsigned long long)pk2(v[j].z * rstd * gv[j].z, v[j].w * rstd * gv[j].w) << 32);
    }
    { const int gt = F.vcu * 512 + F.tid; if (gt < D) { const float l0 = F.lb_logits[gt], l1 = F.lb_logits[D + gt]; F.LB[gt] = 1.0f / (1.0f + expf(l1 - l0)); } }
}

__device__ __forceinline__ void hgrn_slow_item(Frame& F, bool sample, int seq, int h) {
    LAS float* part = (LAS float*)F.lds; LAS float* red = part + 512;
    const int v = F.tid & 127, kq = F.tid >> 7;
    const int row0 = sample ? MP + seq * 4 : seq * SEQ, T = sample ? 4 : SEQ;
    float S[32];
#pragma unroll
    for (int j = 0; j < 32; ++j) S[j] = sample ? F.st_in[((size_t)(seq * 8 + h) * 128 + kq * 32 + j) * 128 + v] : 0.f;
    const float gn = F.a_gnorm[v];
    for (int t = 0; t < T; ++t) {
        bf16* hrow = F.H + (size_t)(row0 + t) * LDH;
        const float vv = bf2f(hrow[HC_VA + h * 128 + v]);
        float acc = 0.f;
#pragma unroll
        for (int j = 0; j < 32; ++j) { const int k = h * 128 + kq * 32 + j; const float q = bf2f(hrow[HC_QA + k]), f = __builtin_amdgcn_exp2f(h2f(hrow[HC_G2 + k]));
            S[j] = f * S[j] + (1.0f - f) * vv; acc += q * S[j]; }
        part[kq * 128 + v] = acc;
        __syncthreads();
        float o = 0.f;
        if (F.tid < 128) { o = (part[v] + part[128 + v]) + (part[256 + v] + part[384 + v]); const float ss = wave_sum(o * o); if (F.lane == 0) red[F.wave] = ss; }
        __syncthreads();
        if (F.tid < 128) { const float r = 1.0f / sqrtf((red[0] + red[1]) * (1.f / 128.f) + EPS);
            hrow[HC_HA + h * 128 + v] = (bf16)f2bf(o * r * gn * bf2f(hrow[HC_ZA + h * 128 + v])); }
    }
    float* so = F.out + (sample ? O_SS : O_SP) + ((size_t)(seq * 8 + h) * 128 + kq * 32) * 128 + v;
#pragma unroll
    for (int j = 0; j < 32; ++j) so[(size_t)j * 128] = S[j];
    __syncthreads();
}
__device__ __forceinline__ float bfw_lo(unsigned w) { return __uint_as_float(w << 16); }
__device__ __forceinline__ float bfw_hi(unsigned w) { return __uint_as_float(w & 0xffff0000u); }
__device__ __forceinline__ void swa_slow(Frame& F, int first, int stride) {
    for (int idx = MP * 16 + first; idx < M * 16; idx += stride) {
        const int m = idx >> 4, head = idx & 15, kvh = head >> 3;
        bf16* qp = F.H + (size_t)m * LDH + HC_QB + head * 64;
        float q[64], o[64];
#pragma unroll
        for (int c = 0; c < 8; ++c) { const v4u w = *(const v4u*)(qp + 8 * c);
            q[8 * c + 0] = bfw_lo(w.x); q[8 * c + 1] = bfw_hi(w.x); q[8 * c + 2] = bfw_lo(w.y); q[8 * c + 3] = bfw_hi(w.y); q[8 * c + 4] = bfw_lo(w.z); q[8 * c + 5] = bfw_hi(w.z); q[8 * c + 6] = bfw_lo(w.w); q[8 * c + 7] = bfw_hi(w.w); }
#pragma unroll
        for (int d = 0; d < 64; ++d) o[d] = 0.f;
        const float slope2 = __builtin_amdgcn_exp2f(-0.5f * (float)(head + 1)) * LOG2E;
        float mx = F.b_sinks[head] * LOG2E, l = 1.0f;
        const bool sample = m >= MP;
        const int ms = m - MP, db = ms >> 2, t = sample ? (ms & 3) : (m & (SEQ - 1));
        const int nk = sample ? 128 : (t < 127 ? t + 1 : 128);
        for (int i = 0; i < nk; ++i) {
            int dist;
            if (sample && i < 127 - t) {
                const int j = t + 1 + i; dist = t + 128 - j;
                const float* kp = F.ck_in + ((size_t)(db * 128 + j) * 2 + kvh) * 64; const float* vp = F.cv_in + ((size_t)(db * 128 + j) * 2 + kvh) * 64;
                float sc = 0.f;
#pragma unroll
                for (int c = 0; c < 16; ++c) { const f32x4 w = *(const f32x4*)(kp + 4 * c); sc += (q[4 * c] * w.x + q[4 * c + 1] * w.y) + (q[4 * c + 2] * w.z + q[4 * c + 3] * w.w); }
                sc -= slope2 * (float)dist;
                const float mn = fmaxf(mx, sc), a = __builtin_amdgcn_exp2f(mx - mn), p = __builtin_amdgcn_exp2f(sc - mn);
                l = l * a + p; mx = mn;
#pragma unroll
                for (int c = 0; c < 16; ++c) { const f32x4 w = *(const f32x4*)(vp + 4 * c);
                    o[4 * c] = o[4 * c] * a + p * w.x; o[4 * c + 1] = o[4 * c + 1] * a + p * w.y; o[4 * c + 2] = o[4 * c + 2] * a + p * w.z; o[4 * c + 3] = o[4 * c + 3] * a + p * w.w; }
            } else {
                int srow; if (sample) { const int s = i - (127 - t); dist = t - s; srow = MP + db * 4 + s; } else { const int s = t - nk + 1 + i; dist = t - s; srow = m - dist; }
                const bf16* kp = F.H + (size_t)srow * LDH + HC_KB + kvh * 64; const bf16* vp = F.H + (size_t)srow * LDH + HC_VB + kvh * 64;
                float sc = 0.f;
#pragma unroll
                for (int c = 0; c < 8; ++c) { const v4u w = *(const v4u*)(kp + 8 * c);
                    sc += (q[8 * c] * bfw_lo(w.x) + q[8 * c + 1] * bfw_hi(w.x)) + (q[8 * c + 2] * bfw_lo(w.y) + q[8 * c + 3] * bfw_hi(w.y)) + (q[8 * c + 4] * bfw_lo(w.z) + q[8 * c + 5] * bfw_hi(w.z)) + (q[8 * c + 6] * bfw_lo(w.w) + q[8 * c + 7] * bfw_hi(w.w)); }
                sc -= slope2 * (float)dist;
                const float mn = fmaxf(mx, sc), a = __builtin_amdgcn_exp2f(mx - mn), p = __builtin_amdgcn_exp2f(sc - mn);
                l = l * a + p; mx = mn;
#pragma unroll
                for (int c = 0; c < 8; ++c) { const v4u w = *(const v4u*)(vp + 8 * c);
                    o[8 * c] = o[8 * c] * a + p * bfw_lo(w.x); o[8 * c + 1] = o[8 * c + 1] * a + p * bfw_hi(w.x); o[8 * c + 2] = o[8 * c + 2] * a + p * bfw_lo(w.y); o[8 * c + 3] = o[8 * c + 3] * a + p * bfw_hi(w.y);
                    o[8 * c + 4] = o[8 * c + 4] * a + p * bfw_lo(w.z); o[8 * c + 5] = o[8 * c + 5] * a + p * bfw_hi(w.z); o[8 * c + 6] = o[8 * c + 6] * a + p * bfw_lo(w.w); o[8 * c + 7] = o[8 * c + 7] * a + p * bfw_hi(w.w); }
            }
        }
        const float rl = 1.0f / l; const bf16* zp = F.H + (size_t)m * LDH + HC_ZB + head * 64;
#pragma unroll
        for (int c = 0; c < 8; ++c) { const v4u z = *(const v4u*)(zp + 8 * c); v4u w;
            w.x = pk2(o[8 * c] * rl * bfw_lo(z.x), o[8 * c + 1] * rl * bfw_hi(z.x)); w.y = pk2(o[8 * c + 2] * rl * bfw_lo(z.y), o[8 * c + 3] * rl * bfw_hi(z.y));
            w.z = pk2(o[8 * c + 4] * rl * bfw_lo(z.z), o[8 * c + 5] * rl * bfw_hi(z.z)); w.w = pk2(o[8 * c + 6] * rl * bfw_lo(z.w), o[8 * c + 7] * rl * bfw_hi(z.w));
            *(v4u*)(qp + 8 * c) = w; }
    }
}
__device__ __forceinline__ void p2_mixers_slow(Frame& F) {
    const int bx = blockIdx.x;
    for (int it = bx; it < 1024; it += F.G) hgrn_slow_item(F, true, it >> 3, it & 7);
    swa_slow(F, bx * 512 + F.tid, F.G * 512);
}


namespace hg {
typedef short bf16x8 __attribute__((ext_vector_type(8)));
typedef float f32x16 __attribute__((ext_vector_type(16)));
typedef float f32x4 __attribute__((ext_vector_type(4)));
typedef float f32x2 __attribute__((ext_vector_type(2)));
typedef unsigned u32x4 __attribute__((ext_vector_type(4)));
typedef unsigned u32x2 __attribute__((ext_vector_type(2)));
constexpr int L_QI = 0, L_KI = 16384, L_KT = 32768, L_VT = 49152, L_SPT = 65536, L_OS = 98304, L_SEG = 114688, L_ER = 118784, L_EB = 119296, L_RS = 119808;
#define HG_MFMA(a, b, c) __builtin_amdgcn_mfma_f32_32x32x16_bf16((a), (b), (c), 0, 0, 0)
__device__ __forceinline__ int img256(int row, int k) { return row * 256 + ((((k >> 3) ^ (row & 15))) << 4) + (k & 7) * 2; }
__device__ __forceinline__ int img128(int row, int s) { return row * 128 + ((((s >> 3) ^ ((row >> 1) & 7))) << 4) + (s & 7) * 2; }
__device__ __forceinline__ int crow(int r, int h) { return (r & 3) + 8 * (r >> 2) + 4 * h; }
__device__ __forceinline__ float ex2(float x) { return __builtin_amdgcn_exp2f(x); }
__device__ __forceinline__ unsigned pkbf(float lo, float hi) { return pg8::cvt_pk_bf16(lo, hi); }
__device__ __forceinline__ float h_lo(unsigned w) { typedef _Float16 h2 __attribute__((ext_vector_type(2))); return (float)__builtin_bit_cast(h2, w).x; }
__device__ __forceinline__ float h_hi(unsigned w) { typedef _Float16 h2 __attribute__((ext_vector_type(2))); return (float)__builtin_bit_cast(h2, w).y; }

template <bool OUT>
__device__ __forceinline__ void hgrn_item(Frame& F, int b, int h, int sc) {
    LAS unsigned char* L = F.lds;
    const int tid = F.tid, lane = F.lane, w = F.wave, hh = lane >> 5, r32 = lane & 31;
    const int kp = lane, ts = w, tb = w & 1, vb = w >> 1, kb0 = 2 * (w & 1);
    const size_t rowb = (size_t)b * SEQ + (size_t)sc * 1024;
    float* Ubase = (float*)(F.ws + WS_HU) + (size_t)(b * 8 + h) * 3 * 16384;
    float* Dbase = (float*)(F.ws + WS_HD) + (size_t)(b * 8 + h) * 3 * 128;
    f32x16 St[2];
#pragma unroll
    for (int i = 0; i < 2; ++i)
#pragma unroll
        for (int r = 0; r < 16; ++r) St[i][r] = 0.f;
    if (OUT) {
        for (int j = 0; j < sc; ++j) {
            const float* U = Ubase + (size_t)j * 16384; const float* Dt = Dbase + j * 128;
#pragma unroll
            for (int i = 0; i < 2; ++i)
#pragma unroll
                for (int g = 0; g < 4; ++g) { const int k0 = (kb0 + i) * 32 + 8 * g + 4 * hh; const f32x4 d = *(const f32x4*)(Dt + k0);
#pragma unroll
                    for (int jj = 0; jj < 4; ++jj) St[i][4 * g + jj] = d[jj] * St[i][4 * g + jj] + U[(size_t)(k0 + jj) * 128 + vb * 32 + r32]; }
        }
    }
    float gsum0 = 0.f, gsum1 = 0.f;
    const int colq = HC_QA + h * 128 + 2 * kp, colg = HC_G2 + h * 128 + 2 * kp, colv = HC_VA + h * 128 + 2 * kp;
    for (int c = 0; c < 16; ++c) {
        const size_t row0 = rowb + (size_t)c * 64;
        unsigned gw[8], qw[8], vw[8];
#pragma unroll
        for (int j = 0; j < 8; ++j) { const bf16* hr = F.H + (row0 + 8 * ts + j) * LDH; gw[j] = *(const unsigned*)(hr + colg); vw[j] = *(const unsigned*)(hr + colv); if (OUT) qw[j] = *(const unsigned*)(hr + colq); else qw[j] = 0u; }
        float c0[8], c1[8];
        { float a0 = 0.f, a1 = 0.f;
#pragma unroll
          for (int j = 0; j < 8; ++j) { a0 += h_lo(gw[j]); a1 += h_hi(gw[j]); c0[j] = a0; c1[j] = a1; }
          *(LAS f32x2*)(L + L_SEG + (ts * 128 + 2 * kp) * 4) = (f32x2){a0, a1}; }
        __syncthreads();
        float off0 = 0.f, off1 = 0.f, rho0 = 0.f, rho1 = 0.f, bl0 = 0.f, bl1 = 0.f;
#pragma unroll
        for (int s = 0; s < 8; ++s) { const f32x2 sg = *(const LAS f32x2*)(L + L_SEG + (s * 128 + 2 * kp) * 4);
            if (s < ts) { off0 += sg.x; off1 += sg.y; } if (s < 4) { rho0 += sg.x; rho1 += sg.y; } bl0 += sg.x; bl1 += sg.y; }
        if (ts == 0) { *(LAS f32x2*)(L + L_ER + 2 * kp * 4) = (f32x2){ex2(rho0), ex2(rho1)}; *(LAS f32x2*)(L + L_EB + 2 * kp * 4) = (f32x2){ex2(bl0 - rho0), ex2(bl1 - rho1)}; gsum0 += bl0; gsum1 += bl1; }
        { unsigned kt0[4], kt1[4], vt0[4], vt1[4];
#pragma unroll
          for (int j = 0; j < 8; j += 2) {
              float kv0[2], kv1[2];
#pragma unroll
              for (int jj = 0; jj < 2; ++jj) { const int t = 8 * ts + j + jj; const float b0 = off0 + c0[j + jj], b1 = off1 + c1[j + jj];
                  const float k0 = (1.0f - ex2(h_lo(gw[j + jj]))) * ex2(fminf(rho0 - b0, 100.f)), k1 = (1.0f - ex2(h_hi(gw[j + jj]))) * ex2(fminf(rho1 - b1, 100.f));
                  kv0[jj] = k0; kv1[jj] = k1;
                  *(LAS unsigned*)(L + L_KI + img256(t, 2 * kp)) = pkbf(k0, k1);
                  if (OUT) { const float q0 = pg8::bf_lo(qw[j + jj]) * ex2(fminf(b0 - rho0, 100.f)), q1 = pg8::bf_hi(qw[j + jj]) * ex2(fminf(b1 - rho1, 100.f));
                      *(LAS unsigned*)(L + L_QI + img256(t, 2 * kp)) = pkbf(q0, q1); } }
              kt0[j >> 1] = pkbf(kv0[0], kv0[1]); kt1[j >> 1] = pkbf(kv1[0], kv1[1]);
              vt0[j >> 1] = (vw[j] & 0xffffu) | (vw[j + 1] << 16); vt1[j >> 1] = (vw[j] >> 16) | (vw[j + 1] & 0xffff0000u); }
          *(LAS u32x4*)(L + L_KT + img128(2 * kp, 8 * ts)) = (u32x4){kt0[0], kt0[1], kt0[2], kt0[3]}; *(LAS u32x4*)(L + L_KT + img128(2 * kp + 1, 8 * ts)) = (u32x4){kt1[0], kt1[1], kt1[2], kt1[3]};
          *(LAS u32x4*)(L + L_VT + img128(2 * kp, 8 * ts)) = (u32x4){vt0[0], vt0[1], vt0[2], vt0[3]}; *(LAS u32x4*)(L + L_VT + img128(2 * kp + 1, 8 * ts)) = (u32x4){vt1[0], vt1[1], vt1[2], vt1[3]}; }
        __syncthreads();
#pragma unroll
        for (int i = 0; i < 2; ++i)
#pragma unroll
            for (int g = 0; g < 4; ++g) { const int k0 = (kb0 + i) * 32 + 8 * g + 4 * hh; const f32x4 er = *(const LAS f32x4*)(L + L_ER + k0 * 4);
#pragma unroll
                for (int jj = 0; jj < 4; ++jj) St[i][4 * g + jj] *= er[jj];
                if (OUT) *(LAS u32x2*)(L + L_SPT + img256(vb * 32 + r32, k0)) = (u32x2){pkbf(St[i][4 * g], St[i][4 * g + 1]), pkbf(St[i][4 * g + 2], St[i][4 * g + 3])}; }
        __syncthreads();
        f32x16 o;
        if (OUT) {
            bf16x8 qf[8];
#pragma unroll
            for (int ks = 0; ks < 8; ++ks) qf[ks] = *(const LAS bf16x8*)(L + L_QI + img256(tb * 32 + r32, 16 * ks + 8 * hh));
#pragma unroll
            for (int r = 0; r < 16; ++r) o[r] = 0.f;
#pragma unroll
            for (int sb = 0; sb < 2; ++sb) {
                if (sb <= tb) {
                    f32x16 X;
#pragma unroll
                    for (int r = 0; r < 16; ++r) X[r] = 0.f;
#pragma unroll
                    for (int ks = 0; ks < 8; ++ks) { const bf16x8 a = *(const LAS bf16x8*)(L + L_KI + img256(sb * 32 + r32, 16 * ks + 8 * hh)); X = HG_MFMA(a, qf[ks], X); }
                    if (sb == tb) {
#pragma unroll
                        for (int r = 0; r < 16; ++r) X[r] = (crow(r, hh) <= r32) ? X[r] : 0.f;
                    }
#pragma unroll
                    for (int k2 = 0; k2 < 2; ++k2) {
                        const u32x4 xs = (u32x4){pkbf(X[8 * k2], X[8 * k2 + 1]), pkbf(X[8 * k2 + 2], X[8 * k2 + 3]), pkbf(X[8 * k2 + 4], X[8 * k2 + 5]), pkbf(X[8 * k2 + 6], X[8 * k2 + 7])};
                        const int s0 = sb * 32 + 16 * k2 + 4 * hh;
                        const u32x2 va = *(const LAS u32x2*)(L + L_VT + img128(vb * 32 + r32, s0)), vbb = *(const LAS u32x2*)(L + L_VT + img128(vb * 32 + r32, s0 + 8));
                        const u32x4 vv = (u32x4){va.x, va.y, vbb.x, vbb.y};
                        o = HG_MFMA(__builtin_bit_cast(bf16x8, vv), __builtin_bit_cast(bf16x8, xs), o);
                    }
                }
            }
#pragma unroll
            for (int ks = 0; ks < 8; ++ks) { const bf16x8 a = *(const LAS bf16x8*)(L + L_SPT + img256(vb * 32 + r32, 16 * ks + 8 * hh)); o = HG_MFMA(a, qf[ks], o); }
        }
#pragma unroll
        for (int i = 0; i < 2; ++i) {
#pragma unroll
            for (int ks = 0; ks < 4; ++ks) { const bf16x8 a = *(const LAS bf16x8*)(L + L_KT + img128((kb0 + i) * 32 + r32, 16 * ks + 8 * hh)), bq = *(const LAS bf16x8*)(L + L_VT + img128(vb * 32 + r32, 16 * ks + 8 * hh));
                St[i] = HG_MFMA(a, bq, St[i]); }
#pragma unroll
            for (int g = 0; g < 4; ++g) { const int k0 = (kb0 + i) * 32 + 8 * g + 4 * hh; const f32x4 eb = *(const LAS f32x4*)(L + L_EB + k0 * 4);
#pragma unroll
                for (int jj = 0; jj < 4; ++jj) St[i][4 * g + jj] *= eb[jj]; }
        }
        if (OUT) {
            float ss = 0.f;
#pragma unroll
            for (int r = 0; r < 16; ++r) ss += o[r] * o[r];
            ss += __shfl_xor(ss, 32);
            if (hh == 0) *(LAS float*)(L + L_RS + ((tb * 4 + vb) * 32 + r32) * 4) = ss;
            __syncthreads();
            float tot = 0.f;
#pragma unroll
            for (int v2 = 0; v2 < 4; ++v2) tot += *(const LAS float*)(L + L_RS + ((tb * 4 + v2) * 32 + r32) * 4);
            const float rn = 1.0f / sqrtf(tot * (1.f / 128.f) + EPS);
#pragma unroll
            for (int g = 0; g < 4; ++g) *(LAS u32x2*)(L + L_OS + img256(tb * 32 + r32, vb * 32 + 8 * g + 4 * hh)) = (u32x2){pkbf(o[4 * g] * rn, o[4 * g + 1] * rn), pkbf(o[4 * g + 2] * rn, o[4 * g + 3] * rn)};
            __syncthreads();
#pragma unroll
            for (int i = 0; i < 2; ++i) { const int t = tid >> 3, cc = (tid & 7) * 2 + i;
                const u32x4 o8 = *(const LAS u32x4*)(L + L_OS + img256(t, 8 * cc));
                bf16* hr = F.H + (row0 + t) * LDH; const u32x4 z8 = *(const u32x4*)(hr + HC_ZA + h * 128 + 8 * cc);
                const f32x4 g0 = *(const f32x4*)(F.a_gnorm + 8 * cc), g1 = *(const f32x4*)(F.a_gnorm + 8 * cc + 4);
                u32x4 r;
                r.x = pkbf(pg8::bf_lo(o8.x) * g0[0] * pg8::bf_lo(z8.x), pg8::bf_hi(o8.x) * g0[1] * pg8::bf_hi(z8.x)); r.y = pkbf(pg8::bf_lo(o8.y) * g0[2] * pg8::bf_lo(z8.y), pg8::bf_hi(o8.y) * g0[3] * pg8::bf_hi(z8.y));
                r.z = pkbf(pg8::bf_lo(o8.z) * g1[0] * pg8::bf_lo(z8.z), pg8::bf_hi(o8.z) * g1[1] * pg8::bf_hi(z8.z)); r.w = pkbf(pg8::bf_lo(o8.w) * g1[2] * pg8::bf_lo(z8.w), pg8::bf_hi(o8.w) * g1[3] * pg8::bf_hi(z8.w));
                *(u32x4*)(hr + HC_HA + h * 128 + 8 * cc) = r; }
        } else {
            __syncthreads();
        }
    }
    if (OUT) {
        if (sc == 3) {
            float* so = F.out + O_SP + (size_t)(b * 8 + h) * 16384;
#pragma unroll
            for (int i = 0; i < 2; ++i)
#pragma unroll
                for (int r = 0; r < 16; ++r) so[(size_t)((kb0 + i) * 32 + crow(r, hh)) * 128 + vb * 32 + r32] = St[i][r];
        }
    } else {
        float* U = Ubase + (size_t)sc * 16384;
#pragma unroll
        for (int i = 0; i < 2; ++i)
#pragma unroll
            for (int r = 0; r < 16; ++r) U[(size_t)((kb0 + i) * 32 + crow(r, hh)) * 128 + vb * 32 + r32] = St[i][r];
        if (ts == 0) *(f32x2*)(Dbase + sc * 128 + 2 * kp) = (f32x2){ex2(gsum0), ex2(gsum1)};
    }
    __syncthreads();
}
#undef HG_MFMA
}


namespace sw {
typedef short bf16x8 __attribute__((ext_vector_type(8)));
typedef float f32x16 __attribute__((ext_vector_type(16)));
typedef unsigned u32x4 __attribute__((ext_vector_type(4)));
typedef unsigned u32x2 __attribute__((ext_vector_type(2)));
constexpr int L_K = 0, L_VT = 32768, L_OST = 65536;
#define SW_MFMA(a, b, c) __builtin_amdgcn_mfma_f32_32x32x16_bf16((a), (b), (c), 0, 0, 0)
__device__ __forceinline__ int img_k(int row, int d) { return row * 128 + ((((d >> 3) ^ ((row >> 1) & 7))) << 4) + (d & 7) * 2; }
__device__ __forceinline__ int img_vt(int row, int key) { return row * 512 + ((((key >> 3) ^ (row & 31))) << 4) + (key & 7) * 2; }
__device__ __forceinline__ int crow(int r, int h) { return (r & 3) + 8 * (r >> 2) + 4 * h; }

__device__ __forceinline__ void swa_unit(Frame& F, int b, int qb, int kvh) {
    LAS unsigned char* L = F.lds;
    const int tid = F.tid, lane = F.lane, g = F.wave, hh_ = lane >> 5, r32_ = lane & 31;
    const long key_row0 = (long)b * SEQ + (long)(qb - 1) * 128;
    const int k_first = qb == 0 ? 128 : 0;
#pragma unroll
    for (int i = 0; i < 4; ++i) { const int idx = tid + 512 * i, key = idx >> 3, ch = idx & 7;
        if (key >= k_first) *(LAS u32x4*)(L + L_K + img_k(key, 8 * ch)) = *(const u32x4*)(F.H + (size_t)(key_row0 + key) * LDH + HC_KB + kvh * 64 + 8 * ch); }
    { const int dp = tid & 31, kg = tid >> 5;
      if (16 * kg >= k_first) {
          unsigned vw[16];
#pragma unroll
          for (int j = 0; j < 16; ++j) vw[j] = *(const unsigned*)(F.H + (size_t)(key_row0 + 16 * kg + j) * LDH + HC_VB + kvh * 64 + 2 * dp);
#pragma unroll
          for (int hf = 0; hf < 2; ++hf) { u32x4 lo, hi;
#pragma unroll
              for (int p = 0; p < 4; ++p) { const unsigned a = vw[8 * hf + 2 * p], c = vw[8 * hf + 2 * p + 1]; lo[p] = (a & 0xffffu) | (c << 16); hi[p] = (a >> 16) | (c & 0xffff0000u); }
              *(LAS u32x4*)(L + L_VT + img_vt(2 * dp, 16 * kg + 8 * hf)) = lo; *(LAS u32x4*)(L + L_VT + img_vt(2 * dp + 1, 16 * kg + 8 * hf)) = hi; }
      } }
    __syncthreads();
    const int head = kvh * 8 + g;
    const float slope2 = __builtin_amdgcn_exp2f(-0.5f * (float)(head + 1)) * LOG2E, sink2 = F.b_sinks[head] * LOG2E;
    LAS unsigned char* ost = L + L_OST + g * 4096;
#pragma unroll 1
    for (int i = 0; i < 4; ++i) {
        int hh = hh_, r32 = r32_;
        asm volatile("" : "+v"(hh), "+v"(r32));
        const size_t tok0 = (size_t)b * SEQ + (size_t)qb * 128 + 32 * i;
        bf16x8 qf[4];
#pragma unroll
        for (int ks = 0; ks < 4; ++ks) qf[ks] = *(const bf16x8*)(F.H + (tok0 + r32) * LDH + HC_QB + head * 64 + 16 * ks + 8 * hh);
        f32x16 X[5];
        float m = sink2;
#pragma unroll
        for (int j = 0; j < 5; ++j) {
            const int kt = i + j;
            if (32 * kt >= k_first) {
                const float tq = slope2 * (float)(32 * j - 128 - r32);
#pragma unroll
                for (int r = 0; r < 16; ++r) { float c0 = slope2 * (float)crow(r, hh) + tq;
                    if (j == 0) c0 = (crow(r, hh) > r32) ? c0 : -INFINITY;
                    if (j == 4) c0 = (crow(r, hh) <= r32) ? c0 : -INFINITY;
                    X[j][r] = c0; }
#pragma unroll
                for (int ks = 0; ks < 4; ++ks) { const bf16x8 a = *(const LAS bf16x8*)(L + L_K + img_k(32 * kt + r32, 16 * ks + 8 * hh)); X[j] = SW_MFMA(a, qf[ks], X[j]); }
#pragma unroll
                for (int r = 0; r < 16; ++r) m = fmaxf(m, X[j][r]);
                __builtin_amdgcn_sched_barrier(0);
            } else {
#pragma unroll
                for (int r = 0; r < 16; ++r) X[j][r] = -INFINITY;
            }
        }
        m = fmaxf(m, __shfl_xor(m, 32));
        float l = 0.f;
#pragma unroll
        for (int j = 0; j < 5; ++j)
#pragma unroll
            for (int r = 0; r < 16; ++r) { const float p = __builtin_amdgcn_exp2f(X[j][r] - m); X[j][r] = p; l += p; }
        l += __shfl_xor(l, 32); l += __builtin_amdgcn_exp2f(sink2 - m);
        f32x16 o[2];
#pragma unroll
        for (int dt = 0; dt < 2; ++dt)
#pragma unroll
            for (int r = 0; r < 16; ++r) o[dt][r] = 0.f;
#pragma unroll
        for (int j = 0; j < 5; ++j) {
            const int kt = i + j;
            if (32 * kt >= k_first) {
#pragma unroll
                for (int k2 = 0; k2 < 2; ++k2) {
                    const u32x4 xs = (u32x4){pg8::cvt_pk_bf16(X[j][8 * k2], X[j][8 * k2 + 1]), pg8::cvt_pk_bf16(X[j][8 * k2 + 2], X[j][8 * k2 + 3]), pg8::cvt_pk_bf16(X[j][8 * k2 + 4], X[j][8 * k2 + 5]), pg8::cvt_pk_bf16(X[j][8 * k2 + 6], X[j][8 * k2 + 7])};
                    const int key0 = 32 * kt + 16 * k2 + 4 * hh;
#pragma unroll
                    for (int dt = 0; dt < 2; ++dt) {
                        const u32x2 va = *(const LAS u32x2*)(L + L_VT + img_vt(dt * 32 + r32, key0)), vb2 = *(const LAS u32x2*)(L + L_VT + img_vt(dt * 32 + r32, key0 + 8));
                        const u32x4 vv = (u32x4){va.x, va.y, vb2.x, vb2.y};
                        o[dt] = SW_MFMA(__builtin_bit_cast(bf16x8, vv), __builtin_bit_cast(bf16x8, xs), o[dt]);
                    }
                    __builtin_amdgcn_sched_barrier(0);
                }
            }
        }
        const float rl = 1.0f / l;
#pragma unroll
        for (int dt = 0; dt < 2; ++dt)
#pragma unroll
            for (int g4 = 0; g4 < 4; ++g4) *(LAS u32x2*)(ost + img_k(r32, dt * 32 + 8 * g4 + 4 * hh)) = (u32x2){pg8::cvt_pk_bf16(o[dt][4 * g4] * rl, o[dt][4 * g4 + 1] * rl), pg8::cvt_pk_bf16(o[dt][4 * g4 + 2] * rl, o[dt][4 * g4 + 3] * rl)};
#pragma unroll
        for (int i4 = 0; i4 < 4; ++i4) { const int idx = lane + 64 * i4, q = idx >> 3, ch = idx & 7;
            const u32x4 o8 = *(const LAS u32x4*)(ost + img_k(q, 8 * ch));
            bf16* hr = F.H + (tok0 + q) * LDH; const u32x4 z8 = *(const u32x4*)(hr + HC_ZB + head * 64 + 8 * ch);
            u32x4 rr;
            rr.x = pg8::cvt_pk_bf16(pg8::bf_lo(o8.x) * pg8::bf_lo(z8.x), pg8::bf_hi(o8.x) * pg8::bf_hi(z8.x)); rr.y = pg8::cvt_pk_bf16(pg8::bf_lo(o8.y) * pg8::bf_lo(z8.y), pg8::bf_hi(o8.y) * pg8::bf_hi(z8.y));
            rr.z = pg8::cvt_pk_bf16(pg8::bf_lo(o8.z) * pg8::bf_lo(z8.z), pg8::bf_hi(o8.z) * pg8::bf_hi(z8.z)); rr.w = pg8::cvt_pk_bf16(pg8::bf_lo(o8.w) * pg8::bf_lo(z8.w), pg8::bf_hi(o8.w) * pg8::bf_hi(z8.w));
            *(u32x4*)(hr + HC_HB + head * 64 + 8 * ch) = rr; }
    }
    __syncthreads();
}
#undef SW_MFMA
}


namespace smp {
typedef short bf16x8 __attribute__((ext_vector_type(8)));
typedef float f32x16 __attribute__((ext_vector_type(16)));
typedef float f32x4 __attribute__((ext_vector_type(4)));
typedef unsigned u32x4 __attribute__((ext_vector_type(4)));
typedef unsigned u32x2 __attribute__((ext_vector_type(2)));
#define SM_MFMA(a, b, c) __builtin_amdgcn_mfma_f32_32x32x16_bf16((a), (b), (c), 0, 0, 0)
__device__ __forceinline__ void swa_sample_unit(Frame& F, int db, int kvh) {
    LAS unsigned char* L = F.lds;
    const int tid = F.tid, lane = F.lane;
    for (int idx = tid; idx < 160 * 8; idx += 512) { const int key = idx >> 3, ch = idx & 7; u32x4 w;
        if (key < 128) { const float* kp = F.ck_in + ((size_t)(db * 128 + key) * 2 + kvh) * 64 + 8 * ch; const f32x4 a = *(const f32x4*)kp, c = *(const f32x4*)(kp + 4);
            w = (u32x4){pg8::cvt_pk_bf16(a[0], a[1]), pg8::cvt_pk_bf16(a[2], a[3]), pg8::cvt_pk_bf16(c[0], c[1]), pg8::cvt_pk_bf16(c[2], c[3])}; }
        else if (key < 132) w = *(const u32x4*)(F.H + (size_t)(MP + db * 4 + key - 128) * LDH + HC_KB + kvh * 64 + 8 * ch);
        else w = (u32x4){0u, 0u, 0u, 0u};
        *(LAS u32x4*)(L + sw::L_K + sw::img_k(key, 8 * ch)) = w; }
    { const int dp = tid & 31, kg = tid >> 5;
      if (kg < 10) {
          float v0[16], v1[16];
#pragma unroll
          for (int j = 0; j < 16; ++j) { const int key = 16 * kg + j;
              if (key < 128) { const float2 a = *(const float2*)(F.cv_in + ((size_t)(db * 128 + key) * 2 + kvh) * 64 + 2 * dp); v0[j] = a.x; v1[j] = a.y; }
              else if (key < 132) { const unsigned a = *(const unsigned*)(F.H + (size_t)(MP + db * 4 + key - 128) * LDH + HC_VB + kvh * 64 + 2 * dp); v0[j] = pg8::bf_lo(a); v1[j] = pg8::bf_hi(a); }
              else { v0[j] = 0.f; v1[j] = 0.f; } }
#pragma unroll
          for (int hf = 0; hf < 2; ++hf) { u32x4 lo, hi;
#pragma unroll
              for (int p = 0; p < 4; ++p) { lo[p] = pg8::cvt_pk_bf16(v0[8 * hf + 2 * p], v0[8 * hf + 2 * p + 1]); hi[p] = pg8::cvt_pk_bf16(v1[8 * hf + 2 * p], v1[8 * hf + 2 * p + 1]); }
              *(LAS u32x4*)(L + sw::L_VT + sw::img_vt(2 * dp, 16 * kg + 8 * hf)) = lo; *(LAS u32x4*)(L + sw::L_VT + sw::img_vt(2 * dp + 1, 16 * kg + 8 * hf)) = hi; }
      } }
    __syncthreads();
    if (F.wave == 0) {
        const int hh = lane >> 5, r32 = lane & 31, t = r32 >> 3, head = kvh * 8 + (r32 & 7);
        const float slope2 = __builtin_amdgcn_exp2f(-0.5f * (float)(head + 1)) * LOG2E, sink2 = F.b_sinks[head] * LOG2E;
        const size_t qrow = (size_t)(MP + db * 4 + t);
        bf16x8 qf[4];
#pragma unroll
        for (int ks = 0; ks < 4; ++ks) qf[ks] = *(const bf16x8*)(F.H + qrow * LDH + HC_QB + head * 64 + 16 * ks + 8 * hh);
        f32x16 X[5];
        float m = sink2;
#pragma unroll
        for (int j = 0; j < 5; ++j) {
#pragma unroll
            for (int r = 0; r < 16; ++r) { const int kj = 32 * j + sw::crow(r, hh); X[j][r] = (kj > t && kj <= 128 + t) ? slope2 * (float)(kj - 128 - t) : -INFINITY; }
#pragma unroll
            for (int ks = 0; ks < 4; ++ks) { const bf16x8 a = *(const LAS bf16x8*)(L + sw::L_K + sw::img_k(32 * j + r32, 16 * ks + 8 * hh)); X[j] = SM_MFMA(a, qf[ks], X[j]); }
#pragma unroll
            for (int r = 0; r < 16; ++r) m = fmaxf(m, X[j][r]);
        }
        m = fmaxf(m, __shfl_xor(m, 32));
        float l = 0.f;
#pragma unroll
        for (int j = 0; j < 5; ++j)
#pragma unroll
            for (int r = 0; r < 16; ++r) { const float p = __builtin_amdgcn_exp2f(X[j][r] - m); X[j][r] = p; l += p; }
        l += __shfl_xor(l, 32); l += __builtin_amdgcn_exp2f(sink2 - m);
        f32x16 o[2];
#pragma unroll
        for (int dt = 0; dt < 2; ++dt)
#pragma unroll
            for (int r = 0; r < 16; ++r) o[dt][r] = 0.f;
#pragma unroll
        for (int j = 0; j < 5; ++j)
#pragma unroll
            for (int k2 = 0; k2 < 2; ++k2) {
                const u32x4 xs = (u32x4){pg8::cvt_pk_bf16(X[j][8 * k2], X[j][8 * k2 + 1]), pg8::cvt_pk_bf16(X[j][8 * k2 + 2], X[j][8 * k2 + 3]), pg8::cvt_pk_bf16(X[j][8 * k2 + 4], X[j][8 * k2 + 5]), pg8::cvt_pk_bf16(X[j][8 * k2 + 6], X[j][8 * k2 + 7])};
                const int key0 = 32 * j + 16 * k2 + 4 * hh;
#pragma unroll
                for (int dt = 0; dt < 2; ++dt) {
                    const u32x2 va = *(const LAS u32x2*)(L + sw::L_VT + sw::img_vt(dt * 32 + r32, key0)), vb2 = *(const LAS u32x2*)(L + sw::L_VT + sw::img_vt(dt * 32 + r32, key0 + 8));
                    const u32x4 vv = (u32x4){va.x, va.y, vb2.x, vb2.y};
                    o[dt] = SM_MFMA(__builtin_bit_cast(bf16x8, vv), __builtin_bit_cast(bf16x8, xs), o[dt]);
                }
            }
        const float rl = 1.0f / l;
        LAS unsigned char* ost = L + sw::L_OST;
#pragma unroll
        for (int dt = 0; dt < 2; ++dt)
#pragma unroll
            for (int g4 = 0; g4 < 4; ++g4) *(LAS u32x2*)(ost + sw::img_k(r32, dt * 32 + 8 * g4 + 4 * hh)) = (u32x2){pg8::cvt_pk_bf16(o[dt][4 * g4] * rl, o[dt][4 * g4 + 1] * rl), pg8::cvt_pk_bf16(o[dt][4 * g4 + 2] * rl, o[dt][4 * g4 + 3] * rl)};
#pragma unroll
        for (int i4 = 0; i4 < 4; ++i4) { const int idx = lane + 64 * i4, q = idx >> 3, ch = idx & 7;
            const u32x4 o8 = *(const LAS u32x4*)(ost + sw::img_k(q, 8 * ch));
            bf16* hr = F.H + (size_t)(MP + db * 4 + (q >> 3)) * LDH; const int hd = kvh * 8 + (q & 7); const u32x4 z8 = *(const u32x4*)(hr + HC_ZB + hd * 64 + 8 * ch);
            u32x4 rr;
            rr.x = pg8::cvt_pk_bf16(pg8::bf_lo(o8.x) * pg8::bf_lo(z8.x), pg8::bf_hi(o8.x) * pg8::bf_hi(z8.x)); rr.y = pg8::cvt_pk_bf16(pg8::bf_lo(o8.y) * pg8::bf_lo(z8.y), pg8::bf_hi(o8.y) * pg8::bf_hi(z8.y));
            rr.z = pg8::cvt_pk_bf16(pg8::bf_lo(o8.z) * pg8::bf_lo(z8.z), pg8::bf_hi(o8.z) * pg8::bf_hi(z8.z)); rr.w = pg8::cvt_pk_bf16(pg8::bf_lo(o8.w) * pg8::bf_lo(z8.w), pg8::bf_hi(o8.w) * pg8::bf_hi(z8.w));
            *(u32x4*)(hr + HC_HB + hd * 64 + 8 * ch) = rr; }
    }
    __syncthreads();
}
#undef SM_MFMA

__device__ __forceinline__ void hgrn_sample_item(Frame& F, int db, int h) {
    LAS float* CO = (LAS float*)F.lds; LAS float* ATT = CO + 9 * 128; LAS float* VV = ATT + 64; LAS float* PART = VV + 512; LAS float* RED = PART + 16 * 512; LAS float* AP = RED + 16;
    const int tid = F.tid, lane = F.lane;
    const size_t row0 = (size_t)MP + db * 4;
    if (tid < 128) {
        const int k = tid; float q[4], kk[4], bb[4]; float acc = 0.f;
#pragma unroll
        for (int t = 0; t < 4; ++t) { const bf16* hr = F.H + (row0 + t) * LDH; q[t] = bf2f(hr[HC_QA + h * 128 + k]); const float g2 = h2f(hr[HC_G2 + h * 128 + k]); acc += g2; bb[t] = acc; kk[t] = 1.0f - __builtin_amdgcn_exp2f(g2);
            VV[t * 128 + k] = bf2f(hr[HC_VA + h * 128 + k]); }
#pragma unroll
        for (int t = 0; t < 4; ++t) { CO[t * 128 + k] = q[t] * __builtin_amdgcn_exp2f(bb[t]); CO[(4 + t) * 128 + k] = kk[t] * __builtin_amdgcn_exp2f(bb[3] - bb[t]); }
        CO[8 * 128 + k] = __builtin_amdgcn_exp2f(bb[3]);
        float a[10]; int n = 0;
#pragma unroll
        for (int t = 0; t < 4; ++t)
#pragma unroll
            for (int s = 0; s <= t; ++s) a[n++] = q[t] * kk[s] * __builtin_amdgcn_exp2f(bb[t] - bb[s]);
#pragma unroll
        for (int i = 0; i < 10; ++i) { const float r = wave_sum(a[i]); if (lane == 0) AP[F.wave * 16 + i] = r; }
    }
    const int v4 = tid & 31, kq = tid >> 5;
    const float* Sin = F.st_in + ((size_t)(db * 8 + h) * 128 + 8 * kq) * 128 + 4 * v4; float* Sout = F.out + O_SS + ((size_t)(db * 8 + h) * 128 + 8 * kq) * 128 + 4 * v4;
    f32x4 S[8];
#pragma unroll
    for (int j = 0; j < 8; ++j) S[j] = *(const f32x4*)(Sin + (size_t)j * 128);
    __syncthreads();
    f32x4 vs[4];
#pragma unroll
    for (int s = 0; s < 4; ++s) vs[s] = *(const LAS f32x4*)(VV + s * 128 + 4 * v4);
    f32x4 op[4];
#pragma unroll
    for (int t = 0; t < 4; ++t) op[t] = (f32x4){0.f, 0.f, 0.f, 0.f};
#pragma unroll
    for (int j = 0; j < 8; ++j) { const int k = 8 * kq + j;
#pragma unroll
        for (int t = 0; t < 4; ++t) op[t] += S[j] * CO[t * 128 + k];
        f32x4 sn = S[j] * CO[8 * 128 + k];
#pragma unroll
        for (int s = 0; s < 4; ++s) sn += vs[s] * CO[(4 + s) * 128 + k];
        *(f32x4*)(Sout + (size_t)j * 128) = sn; }
#pragma unroll
    for (int t = 0; t < 4; ++t) *(LAS f32x4*)(PART + (kq * 4 + t) * 128 + 4 * v4) = op[t];
    __syncthreads();
    { const int t = tid >> 7, v = tid & 127; float o = 0.f;
#pragma unroll
      for (int g = 0; g < 16; ++g) o += PART[(g * 4 + t) * 128 + v];
      for (int s = 0; s <= t; ++s) { const int n = t * (t + 1) / 2 + s; o += (AP[n] + AP[16 + n]) * VV[s * 128 + v]; }
      const float ss = wave_sum(o * o); if (lane == 0) RED[F.wave] = ss;
      __syncthreads();
      const float tot = RED[2 * t] + RED[2 * t + 1]; const float r = 1.0f / sqrtf(tot * (1.f / 128.f) + EPS);
      bf16* hr = F.H + (row0 + t) * LDH;
      hr[HC_HA + h * 128 + v] = (bf16)f2bf(o * r * F.a_gnorm[v] * bf2f(hr[HC_ZA + h * 128 + v])); }
    __syncthreads();
}
}

__device__ __forceinline__ void p5_final_norm(Frame& F) {
    const int gw = F.vcu * NWAVES + F.wave, NGW = F.G * NWAVES;
    f32x4 gv[4];
#pragma unroll
    for (int j = 0; j < 4; ++j) gv[j] = ((const f32x4*)F.norm_final)[F.lane + 64 * j];
    for (int m = gw; m < M; m += NGW) {
        float s = F.lane < 16 ? F.SSQ[(size_t)m * 16 + F.lane] : 0.f;
        s += __shfl_xor(s, 1); s += __shfl_xor(s, 2); s += __shfl_xor(s, 4); s += __shfl_xor(s, 8);
        s = __shfl(s, 0);
        const float rstd = 1.0f / sqrtf(s * (1.f / D) + EPS);
        const f32x4* yt = (const f32x4*)(F.H + (size_t)m * LDH + HC_QB) + F.lane; f32x4* yr = (f32x4*)(F.out + O_Y + (size_t)m * D) + F.lane;
#pragma unroll
        for (int j = 0; j < 4; ++j) { f32x4 y = yt[64 * j]; y = y * rstd * gv[j]; yr[64 * j] = y; }
    }
    { const int gt = F.vcu * 512 + F.tid, NT = F.G * 512;
      for (int i = gt; i < 128 * 128 * 32; i += NT) { const int c4 = (i & 31) * 4, rl = i >> 5, db = rl >> 7, l = rl & 127; const size_t dof = (size_t)rl * 128 + c4;
          f32x4 k, v; if (l < 124) { const size_t so = (size_t)(rl + 4) * 128 + c4; k = *(const f32x4*)(F.ck_in + so); v = *(const f32x4*)(F.cv_in + so); }
          else { const size_t so = (size_t)(db * 4 + (l - 124)) * 128 + c4; k = *(const f32x4*)(F.CKSN + so); v = *(const f32x4*)(F.CVSN + so); }
          *(f32x4*)(F.out + O_CKS + dof) = k; *(f32x4*)(F.out + O_CVS + dof) = v; }
      for (int i = gt; i < 8 * 128 * 32; i += NT) { const size_t o = (size_t)i * 4; *(f32x4*)(F.out + O_CKP + o) = *(const f32x4*)(F.CKP + o); *(f32x4*)(F.out + O_CVP + o) = *(const f32x4*)(F.CVP + o); } }
}

struct Args { const float* in[14]; float* out; unsigned char* ws; int ph_lo, ph_hi, li, pad; };
__global__ void __launch_bounds__(NWAVES * 64, 2) fwd(Args args) {
    extern __shared__ __attribute__((aligned(16))) unsigned char lds[];
    Frame F;
    F.lds = (LAS unsigned char*)lds;
    F.tid = threadIdx.x; F.lane = F.tid & 63; F.wave = __builtin_amdgcn_readfirstlane(F.tid >> 6);
    F.G = gridDim.x; { const int bx = blockIdx.x; F.vcu = (F.G % 8 == 0) ? (bx % 8) * (F.G / 8) + bx / 8 : bx; }
    F.xp = args.in[0]; F.xs = args.in[1]; F.st_in = args.in[2]; F.ck_in = args.in[3]; F.cv_in = args.in[4]; F.norm_in = args.in[5]; F.w_in = args.in[6]; F.lb_logits = args.in[7];
    F.a_gnorm = args.in[8]; F.b_sinks = args.in[9]; F.w_pa = args.in[10]; F.w_pb = args.in[11]; F.w_out = args.in[12]; F.norm_final = args.in[13];
    F.out = args.out; F.ws = args.ws; unsigned char* ws = args.ws;
    F.Win_t = (bf16*)(ws + WS_WIN); F.Wpa_t = (bf16*)(ws + WS_WPA); F.Wpb_t = (bf16*)(ws + WS_WPB); F.Wout_t = (bf16*)(ws + WS_WOUT);
    F.XN = (bf16*)(ws + WS_XN); F.H = (bf16*)(ws + WS_H); F.LB = (float*)(ws + WS_LB); F.SSQ = (float*)(ws + WS_SSQ);
    F.CKP = (float*)(ws + WS_CKP); F.CVP = (float*)(ws + WS_CVP); F.CKSN = (float*)(ws + WS_CKSN); F.CVSN = (float*)(ws + WS_CVSN);
    volatile LAS unsigned* MISC = (volatile LAS unsigned*)(F.lds + MISC_OFF);
    for (int u = F.tid; u < (LDS_BYTES - LDSCTL_OFF) / 4; u += NWAVES * 64) ((LAS unsigned*)(F.lds + LDSCTL_OFF))[u] = 0u;
    __syncthreads();
    XcdBarrier bar; bar.bar = (unsigned*)(ws + WS_CTL) + CW_BAR; bar.x = 0; bar.st = nullptr;
    if (N_LAUNCHES == 1) bar = xcd_barrier_post((unsigned*)(ws + WS_CTL) + CW_BAR, MISC + 8);
    const int lo = args.ph_lo, hi = args.ph_hi;
#define IN(k) (lo <= (k) && (k) < hi)
#define SEAM(k) do { if (IN(k) && IN((k) + 1)) xcd_barrier(bar); } while (0)

    if (IN(0)) { p0_prologue(F); SEAM(0); }
    if (IN(1)) {
        pg8::Gemm g{F.XN, F.XN, F.Win_t, F.Win_t, D, D, D}; pg8::StaticOrder S; S.init(M, NMIX, F.G, (int)blockIdx.x, 0);
        pg8::EpiIn E{F.H, F.LB, F.CKP, F.CVP, F.CKSN, F.CVSN, 0};
        pg8::gemm_phase<pg8::EpiIn, pg8::StaticOrder>(F.lds, g, S, E);
        SEAM(1);
    }
    if (IN(2)) {
        for (int it = blockIdx.x; it < 192; it += F.G) hg::hgrn_item<false>(F, it / 24, (it / 3) & 7, it % 3);
        for (int it = blockIdx.x; it < 1024; it += F.G) smp::hgrn_sample_item(F, it >> 3, it & 7);
        for (int it = blockIdx.x; it < 256; it += F.G) smp::swa_sample_unit(F, it >> 1, it & 1);
        for (int it = blockIdx.x; it < 512; it += F.G) sw::swa_unit(F, it >> 6, (it >> 1) & 31, it & 1);
        SEAM(2); }
    if (IN(3)) {
        for (int it = blockIdx.x; it < 256; it += F.G) hg::hgrn_item<true>(F, it >> 5, (it >> 2) & 7, it & 3);
        SEAM(3); }
    if (IN(4)) {
        pg8::Gemm g{F.XN, F.XN, F.Win_t + (size_t)NMIX * D, F.Win_t + (size_t)NMIX * D, D, D, D}; pg8::StaticOrder S; S.init(M, 2048, F.G, (int)blockIdx.x, 0);
        pg8::EpiIn E{F.H, F.LB, F.CKP, F.CVP, F.CKSN, F.CVSN, 1};
        pg8::gemm_phase<pg8::EpiIn, pg8::StaticOrder>(F.lds, g, S, E);
        SEAM(4);
    }
    if (IN(5)) {
        pg8::Gemm g{F.H + HC_HA, F.H + HC_HB, F.Wpa_t, F.Wpb_t, LDH, D, D}; pg8::StaticOrder S; S.init(M, D, F.G, (int)blockIdx.x, 1);
        pg8::EpiMerge E{F.H, F.H + HC_MG};
        pg8::gemm_phase<pg8::EpiMerge, pg8::StaticOrder>(F.lds, g, S, E);
        SEAM(5);
    }
    if (IN(6)) {
        pg8::Gemm g{F.H + HC_MG, F.H + HC_MG, F.Wout_t, F.Wout_t, LDH, D, D}; pg8::StaticOrder S; S.init(M, D, F.G, (int)blockIdx.x, 0);
        pg8::EpiOut E{F.xp, F.xs, F.H + HC_QB, F.SSQ};
        pg8::gemm_phase<pg8::EpiOut, pg8::StaticOrder>(F.lds, g, S, E);
        SEAM(6);
    }
    if (IN(7)) { p5_final_norm(F); }
#undef IN
#undef SEAM
}

extern "C" void kernel_launch(void* const* d_in, const int* in_sizes, int n_in, void* d_out, int out_size, void* d_ws, size_t ws_size, hipStream_t stream) {
    static int grid = 0;
    if (grid == 0) {
        if (n_in != 14 || (size_t)out_size != O_END || ws_size < WS_HD + MiB) { fprintf(stderr, "kernel_launch: unexpected shapes: n_in %d out %d ws %zu (need %zu)\n", n_in, out_size, ws_size, (size_t)WS_END); grid = -1; return; }
        int dev = 0, cus = 0;
        if (hipGetDevice(&dev) != hipSuccess || hipDeviceGetAttribute(&cus, hipDeviceAttributeMultiprocessorCount, dev) != hipSuccess) { grid = -1; return; }
        if (hipFuncSetAttribute((const void*)fwd, hipFuncAttributeMaxDynamicSharedMemorySize, LDS_BYTES) != hipSuccess) { fprintf(stderr, "kernel_launch: hipFuncSetAttribute failed\n"); grid = -1; return; }
        int per_cu = 0;
        (void)hipOccupancyMaxActiveBlocksPerMultiprocessor(&per_cu, (const void*)fwd, NWAVES * 64, LDS_BYTES);
        (void)hipGetLastError();
        grid = cus;
    }
    if (grid < 0) return;
    (void)hipMemsetAsync((char*)d_ws + WS_CTL, 0, CTL_ZERO_BYTES, stream);
    Args a{};
    for (int i = 0; i < 14; ++i) a.in[i] = (const float*)d_in[i];
    a.out = (float*)d_out; a.ws = (unsigned char*)d_ws;
    for (int li = 0; li < N_LAUNCHES; ++li) {
        a.ph_lo = (N_LAUNCHES == 1) ? 0 : li; a.ph_hi = (N_LAUNCHES == 1) ? NPHASE : li + 1; a.li = li;
        hipLaunchKernelGGL(fwd, dim3(grid), dim3(NWAVES * 64), LDS_BYTES, stream, a);
    }
}
```

```cpp
#include <hip/hip_runtime.h>
#include <cstdio>
#include <cstdint>

#ifndef MK_N_LAUNCHES
#define MK_N_LAUNCHES 1
#endif

constexpr int D = 1024, MP = 32768, MS = 512, M = MP + MS, SEQ = 4096, NIN = 8448;
constexpr int LDH = 6400;
constexpr int HC_QA = 0, HC_G2 = 1024, HC_VA = 2048, HC_ZA = 3072, HC_QB = 4096, HC_KB = 5120, HC_VB = 5248, HC_ZB = 5376;
constexpr int HC_HA = HC_VA, HC_HB = HC_QB, HC_GA = 0, HC_GB = 1024, HC_MG = HC_ZA;
constexpr int NMIX = 6400;
constexpr float EPS = 1e-6f, LOG2E = 1.4426950408889634f, C2 = 0.125f * 1.4426950408889634f;
constexpr size_t O_Y = 0, O_SP = 34078720, O_CKP = 35127296, O_CVP = 35258368, O_SS = 35389440, O_CKS = 52166656, O_CVS = 54263808, O_END = 56360960;
constexpr size_t MiB = 1u << 20;
constexpr size_t WS_CTL = 0, CTL_ZERO_BYTES = 1 * MiB;
constexpr size_t WS_LB = 1 * MiB;
constexpr size_t WS_CKP = 1 * MiB + 65536, WS_CVP = WS_CKP + 524288, WS_CKSN = WS_CVP + 524288, WS_CVSN = WS_CKSN + 262144;
constexpr size_t WS_WIN = 3 * MiB;
constexpr size_t WS_WPA = 20 * MiB, WS_WPB = 22 * MiB, WS_WOUT = 24 * MiB;
constexpr size_t WS_XN = 26 * MiB;
constexpr size_t WS_SSQ = 26 * MiB;
constexpr size_t WS_H = 91 * MiB;
constexpr size_t WS_END = WS_H + (size_t)M * LDH * 2;
constexpr size_t WS_HU = 498 * MiB, WS_HD = 512 * 1024;
constexpr size_t WS_GABS = 510 * MiB;
constexpr size_t WS_SSQS = 32 * MiB;
static_assert(WS_CVSN + 262144 <= WS_WIN && WS_XN + (size_t)M * D * 2 <= WS_H && WS_END <= WS_HU && WS_HU + 12 * MiB <= WS_GABS && WS_GABS + 2 * MiB <= 512 * MiB, "ws map");

namespace pg8 {
#define PG8_LAS __attribute__((address_space(3)))
typedef unsigned short bf16_t;
typedef short bf16x8 __attribute__((ext_vector_type(8)));
typedef float f32x4 __attribute__((ext_vector_type(4)));
typedef unsigned u32x4 __attribute__((ext_vector_type(4)));
constexpr int BM = 256, BK = 64, HALF = 128, HTB = HALF * BK * 2, STAGE_BYTES = 8 * HTB, NXCD = 8, WGM = 8;

__host__ __device__ __forceinline__ int lds_byte(int r, int c) { const int st = (r >> 4) * 2 + (c >> 5), rr = r & 15, cc = c & 31, ob = rr * 64 + cc * 2; return st * 1024 + (ob ^ (((ob >> 9) & 1) << 5)); }
__host__ __device__ __forceinline__ void stage_rc(int b, int& R, int& C) { const int st = b / 1024, sb = b % 1024, swz = sb ^ (((sb >> 9) & 1) << 5); R = (st >> 1) * 16 + swz / 64; C = (st & 1) * 32 + (swz % 64) / 2; }
__host__ __device__ __forceinline__ int perm32(int rho) { const int n = rho >> 4, i = rho & 15; return 8 * (i >> 2) + 4 * n + (i & 3); }

struct Unit { int pm, pn, sub; };
struct Gemm { const bf16_t *A0, *A1, *B0, *B1; int lda, ldb, K; };

struct StaticOrder {
    int nM, nN, nwg, G, c, dbl, nextra;
    __host__ __device__ void init(int M_, int N_, int G_, int c_, int dbl_, int nextra_ = 0) { nM = M_ / BM; nN = N_ / BM; nwg = nM * nN; G = G_; c = c_; dbl = dbl_; nextra = nextra_; }
    __host__ __device__ bool next(int i, Unit& u) const {
        const int it = dbl ? (i >> 1) : i; u.sub = dbl ? (i & 1) : 0;
        const long L = (long)it * G + c; if (L >= nwg + nextra) return false;
        if (L >= nwg) { const int e = (int)L - nwg; u.pm = 128 + (e & 1); u.pn = 25 + (e >> 1); return true; }
        int wgid = (int)L; { const int q = nwg / NXCD, r = nwg % NXCD, xcd = wgid % NXCD, off = wgid / NXCD; wgid = (xcd < r ? xcd * (q + 1) : r * (q + 1) + (xcd - r) * q) + off; }
        const int nig = WGM * nN, gid = wgid / nig, fm = gid * WGM, gsz = (nM - fm) < WGM ? (nM - fm) : WGM;
        u.pm = fm + ((wgid % nig) % gsz); u.pn = (wgid % nig) / gsz; return true;
    }
};

typedef float f32x2_t __attribute__((ext_vector_type(2))); typedef __bf16 bf16x2_t __attribute__((ext_vector_type(2)));
__device__ __forceinline__ unsigned cvt_pk_bf16(float lo, float hi) { f32x2_t v = {lo, hi}; bf16x2_t b = __builtin_convertvector(v, bf16x2_t); return __builtin_bit_cast(unsigned, b); }
__device__ __forceinline__ float bf_lo(unsigned w) { return __uint_as_float(w << 16); }
__device__ __forceinline__ float bf_hi(unsigned w) { return __uint_as_float(w & 0xffff0000u); }

typedef f32x4 Acc[2][2][4][2];

template <class Epi, class Sched>
__device__ __forceinline__ void gemm_phase(PG8_LAS unsigned char* lds, const Gemm g, const Sched& S, const Epi& E) {
    const int tid = threadIdx.x, wid = __builtin_amdgcn_readfirstlane(tid >> 6), lane = tid & 63, wr = wid >> 2, wc = wid & 3, fr = lane & 15, fq = lane >> 4;
    const int K = g.K, nt = K / BK;
    unsigned voffA[2], voffB[2];
#pragma unroll
    for (int i = 0; i < 2; ++i) { int R, C; stage_rc(tid * 16 + i * 8192, R, C); const int Rb = Epi::PERM ? ((R & ~31) + perm32(R & 31)) : R;
        voffA[i] = (unsigned)(R * g.lda + C) * 2u; voffB[i] = (unsigned)(Rb * g.ldb + C) * 2u; }
    const size_t kstep = (size_t)(BK * 2);
    const size_t hstepA = (size_t)HALF * g.lda * 2, hstepB = (size_t)HALF * g.ldb * 2;
    const size_t tstepA = 2 * hstepA, tstepB = 2 * hstepB;
    const unsigned ldsw = (unsigned)wid * 1024u;
    const int aoff = lds_byte(wr * 64 + fr, fq * 8), boff = lds_byte(wc * 32 + fr, fq * 8);
#define PG8_SA(b, h) (((b) * 2 + (h)) * HTB)
#define PG8_SB(b, h) ((4 + (b) * 2 + (h)) * HTB)
#define PG8_STAGE(bufoff, gbase, voff) do { _Pragma("unroll") for (int _i = 0; _i < 2; ++_i) \
        __builtin_amdgcn_global_load_lds((const unsigned*)((const char*)(gbase) + (voff)[_i]), (PG8_LAS unsigned*)(lds + (bufoff) + ldsw + _i * 8192), 16, 0, 0); } while (0)
#define PG8_LDA(dst, b, h) do { _Pragma("unroll") for (int m = 0; m < 4; ++m) _Pragma("unroll") for (int k = 0; k < 2; ++k) dst[m][k] = *(const PG8_LAS bf16x8*)(lds + PG8_SA(b, h) + aoff + m * 2048 + k * 1024); } while (0)
#define PG8_LDB(dst, b, h) do { _Pragma("unroll") for (int n = 0; n < 2; ++n) _Pragma("unroll") for (int k = 0; k < 2; ++k) dst[n][k] = *(const PG8_LAS bf16x8*)(lds + PG8_SB(b, h) + boff + n * 2048 + k * 1024); } while (0)
#define PG8_MMA(ai, bj, At, Bt) do { __builtin_amdgcn_s_setprio(1); _Pragma("unroll") for (int m = 0; m < 4; ++m) _Pragma("unroll") for (int n = 0; n < 2; ++n) _Pragma("unroll") for (int k = 0; k < 2; ++k) \
        acc[ai][bj][m][n] = __builtin_amdgcn_mfma_f32_16x16x32_bf16(Bt[n][k], At[m][k], acc[ai][bj][m][n], 0, 0, 0); __builtin_amdgcn_s_setprio(0); } while (0)
#define PG8_WAIT_V(n) asm volatile("s_waitcnt vmcnt(" #n ")" ::: "memory")
#define PG8_WAIT_L(n) asm volatile("s_waitcnt lgkmcnt(" #n ")" ::: "memory")
#define PG8_BAR __builtin_amdgcn_s_barrier()
#define PG8_SCHED __builtin_amdgcn_sched_barrier(0)
    Unit cur, nxt; int ui = 0;
    if (!S.next(0, cur)) return;
    Acc acc;
#pragma unroll
    for (int a = 0; a < 2; ++a)
#pragma unroll
        for (int b = 0; b < 2; ++b)
#pragma unroll
            for (int m = 0; m < 4; ++m)
#pragma unroll
                for (int n = 0; n < 2; ++n) acc[a][b][m][n] = (f32x4){0.f, 0.f, 0.f, 0.f};
    bf16x8 At[4][2], B0[2][2], B1[2][2];
    const char* cA = (const char*)(cur.sub ? g.A1 : g.A0) + (size_t)cur.pm * tstepA; const char* cB = (const char*)(cur.sub ? g.B1 : g.B0) + (size_t)cur.pn * tstepB;
    PG8_STAGE(PG8_SB(0, 0), cB, voffB); PG8_STAGE(PG8_SB(0, 1), cB + hstepB, voffB); PG8_STAGE(PG8_SA(0, 0), cA, voffA); PG8_STAGE(PG8_SA(0, 1), cA + hstepA, voffA);
    if (wr == 1) PG8_BAR;
    PG8_WAIT_V(2); PG8_BAR;
    PG8_STAGE(PG8_SB(1, 0), cB + kstep, voffB); PG8_STAGE(PG8_SA(1, 0), cA + kstep, voffA); PG8_STAGE(PG8_SB(1, 1), cB + hstepB + kstep, voffB);
    PG8_WAIT_V(6); PG8_BAR;
    for (;;) {
        const bool has_next = S.next(ui + 1, nxt);
        const char* nA = has_next ? (const char*)(nxt.sub ? g.A1 : g.A0) + (size_t)nxt.pm * tstepA : cA; const char* nB = has_next ? (const char*)(nxt.sub ? g.B1 : g.B0) + (size_t)nxt.pn * tstepB : cB;
        for (int t = 0; t < nt; t += 2) {
            const bool last = (t == nt - 2);
            const char* a1 = cA + (size_t)(t + 1) * kstep;
            const char* a2 = last ? nA : cA + (size_t)(t + 2) * kstep; const char* b2 = last ? nB : cB + (size_t)(t + 2) * kstep;
            const char* a3 = a2 + kstep; const char* b3 = b2 + kstep;
            PG8_LDB(B0, 0, 0); PG8_LDB(B1, 0, 1); PG8_SCHED; PG8_LDA(At, 0, 0); PG8_STAGE(PG8_SA(1, 1), a1 + hstepA, voffA);
            PG8_WAIT_V(8); PG8_WAIT_L(0); PG8_BAR; PG8_MMA(0, 0, At, B0); PG8_MMA(0, 1, At, B1); PG8_BAR; PG8_SCHED;
            PG8_LDA(At, 0, 1); PG8_STAGE(PG8_SB(0, 0), b2, voffB); PG8_STAGE(PG8_SB(0, 1), b2 + hstepB, voffB); PG8_STAGE(PG8_SA(0, 0), a2, voffA);
            PG8_WAIT_V(8); PG8_WAIT_L(0); PG8_BAR; PG8_MMA(1, 0, At, B0); PG8_MMA(1, 1, At, B1); PG8_BAR; PG8_SCHED;
            PG8_LDB(B0, 1, 0); PG8_LDB(B1, 1, 1); PG8_SCHED; PG8_LDA(At, 1, 0); PG8_STAGE(PG8_SA(0, 1), a2 + hstepA, voffA);
            PG8_WAIT_V(8); PG8_WAIT_L(0); PG8_BAR; PG8_MMA(0, 0, At, B0); PG8_MMA(0, 1, At, B1); PG8_BAR; PG8_SCHED;
            PG8_LDA(At, 1, 1); PG8_STAGE(PG8_SB(1, 0), b3, voffB); PG8_STAGE(PG8_SB(1, 1), b3 + hstepB, voffB); PG8_STAGE(PG8_SA(1, 0), a3, voffA);
            PG8_WAIT_V(8); PG8_WAIT_L(0); PG8_BAR; PG8_MMA(1, 0, At, B0); PG8_MMA(1, 1, At, B1); PG8_BAR; PG8_SCHED;
        }
        if (wr == 0) PG8_BAR;
        const bool keep = E(acc, cur, wr, wc, fr, fq);
        if (!has_next) break;
        if (!keep) {
#pragma unroll
        for (int a = 0; a < 2; ++a)
#pragma unroll
            for (int b = 0; b < 2; ++b)
#pragma unroll
                for (int m = 0; m < 4; ++m)
#pragma unroll
                    for (int n = 0; n < 2; ++n) acc[a][b][m][n] = (f32x4){0.f, 0.f, 0.f, 0.f};
        }
        cur = nxt; cA = nA; cB = nB; ++ui;
        if (wr == 1) PG8_BAR;
    }
    PG8_WAIT_V(0);
    PG8_BAR;
#undef PG8_SA
#undef PG8_SB
#undef PG8_STAGE
#undef PG8_LDA
#undef PG8_LDB
#undef PG8_MMA
#undef PG8_WAIT_V
#undef PG8_WAIT_L
#undef PG8_BAR
#undef PG8_SCHED
}

__device__ __forceinline__ float sigmoidf_(float x) { return __builtin_amdgcn_rcpf(1.0f + __builtin_amdgcn_exp2f(-x * LOG2E)); }
__device__ __forceinline__ float siluf_(float x) { return x * sigmoidf_(x); }
__device__ __forceinline__ unsigned cvt_pk_f16(float lo, float hi) { typedef _Float16 h2 __attribute__((ext_vector_type(2))); h2 v; v.x = (_Float16)lo; v.y = (_Float16)hi; return __builtin_bit_cast(unsigned, v); }

struct EpiIn {
    static constexpr bool PERM = true;
    bf16_t* H; const float* lb; float *ckp, *cvp, *cksn, *cvsn; int gate; bf16_t* gabs;
    template <int MODE> __device__ __forceinline__ void run(Acc& acc, const Unit& u, int wr, int wc, int fr, int fq) const {
        const int row0 = u.pm * BM + wr * 64 + fr, cb = wc * 32 + 8 * fq;
        bf16_t* base; int ld;
        if (MODE == 4 && !gate) { base = gabs - (size_t)MP * 2048 + (u.pn - 25) * 256 + cb; ld = 2048; } else { base = H + u.pn * 256 + cb; ld = LDH; }
        float lbv[2][8];
        if (MODE == 2) {
#pragma unroll
            for (int bj = 0; bj < 2; ++bj) { const f32x4 a = *(const f32x4*)(lb + (u.pn - 4) * 256 + bj * HALF + cb), b = *(const f32x4*)(lb + (u.pn - 4) * 256 + bj * HALF + cb + 4);
                lbv[bj][0] = a[0]; lbv[bj][1] = a[1]; lbv[bj][2] = a[2]; lbv[bj][3] = a[3]; lbv[bj][4] = b[0]; lbv[bj][5] = b[1]; lbv[bj][6] = b[2]; lbv[bj][7] = b[3]; }
        }
#pragma unroll
        for (int ai = 0; ai < 2; ++ai)
#pragma unroll
            for (int m = 0; m < 4; ++m) { const int row = row0 + ai * HALF + m * 16; bf16_t* rowp = base + (size_t)row * ld;
#pragma unroll
                for (int bj = 0; bj < 2; ++bj) { float v[8];
#pragma unroll
                    for (int j = 0; j < 4; ++j) { v[j] = acc[ai][bj][m][0][j]; v[4 + j] = acc[ai][bj][m][1][j]; }
                    if (MODE == 5) {
                        float* dst = nullptr;
                        if (row < MP) { const int t = row & (SEQ - 1); if (t >= SEQ - 128) dst = (bj ? cvp : ckp) + ((size_t)((row >> 12) * 128 + (t - (SEQ - 128))) * 128 + cb); }
                        else { const int ms = row - MP; dst = (bj ? cvsn : cksn) + ((size_t)ms * 128 + cb); }
                        if (dst) { *(f32x4*)dst = acc[ai][bj][m][0]; *(f32x4*)(dst + 4) = acc[ai][bj][m][1]; }
                    }
                    u32x4 w;
                    if (MODE == 2) {
#pragma unroll
                        for (int j = 0; j < 8; ++j) { const float l = lbv[bj][j]; v[j] = __builtin_amdgcn_logf(l + (1.0f - l) * sigmoidf_(v[j])); }
                        w.x = cvt_pk_f16(v[0], v[1]); w.y = cvt_pk_f16(v[2], v[3]); w.z = cvt_pk_f16(v[4], v[5]); w.w = cvt_pk_f16(v[6], v[7]);
                    } else {
#pragma unroll
                        for (int j = 0; j < 8; ++j) { if (MODE == 1) v[j] = siluf_(v[j]); if (MODE == 3) v[j] *= C2; if (MODE == 4) v[j] = sigmoidf_(v[j]); }
                        w.x = cvt_pk_bf16(v[0], v[1]); w.y = cvt_pk_bf16(v[2], v[3]); w.z = cvt_pk_bf16(v[4], v[5]); w.w = cvt_pk_bf16(v[6], v[7]);
                    }
                    *(u32x4*)(rowp + bj * HALF) = w; } }
    }
    __device__ __forceinline__ bool operator()(Acc& acc, const Unit& u, int wr, int wc, int fr, int fq) const {
        const int pn = u.pn;
        if (gate) { run<4>(acc, u, wr, wc, fr, fq); return false; }
        if (pn < 4) run<1>(acc, u, wr, wc, fr, fq);
        else if (pn < 8) run<2>(acc, u, wr, wc, fr, fq);
        else if (pn < 12) run<0>(acc, u, wr, wc, fr, fq);
        else if (pn < 16) run<1>(acc, u, wr, wc, fr, fq);
        else if (pn < 20) run<3>(acc, u, wr, wc, fr, fq);
        else if (pn == 20) run<5>(acc, u, wr, wc, fr, fq);
        else if (pn < 25) run<1>(acc, u, wr, wc, fr, fq);
        else run<4>(acc, u, wr, wc, fr, fq);
        return false;
    }
};

struct EpiMerge {
    static constexpr bool PERM = true;
    const bf16_t* HG; bf16_t* MG;
    __device__ __forceinline__ bool operator()(Acc& acc, const Unit& u, int wr, int wc, int fr, int fq) const {
        const int row0 = u.pm * BM + wr * 64 + fr, col0 = u.pn * BM + wc * 32 + 8 * fq;
#pragma unroll
        for (int ai = 0; ai < 2; ++ai)
#pragma unroll
            for (int m = 0; m < 4; ++m) { const int row = row0 + ai * HALF + m * 16; const bf16_t* gp = HG + (size_t)row * LDH + col0;
#pragma unroll
                for (int bj = 0; bj < 2; ++bj) {
                    const u32x4 gb = *(const u32x4*)(gp + 1024 + bj * HALF);
                    float b[8] = {bf_lo(gb.x), bf_hi(gb.x), bf_lo(gb.y), bf_hi(gb.y), bf_lo(gb.z), bf_hi(gb.z), bf_lo(gb.w), bf_hi(gb.w)};
                    if (u.sub == 0) {
                        const u32x4 ga = *(const u32x4*)(gp + bj * HALF);
                        float a[8] = {bf_lo(ga.x), bf_hi(ga.x), bf_lo(ga.y), bf_hi(ga.y), bf_lo(ga.z), bf_hi(ga.z), bf_lo(ga.w), bf_hi(ga.w)};
#pragma unroll
                        for (int j = 0; j < 4; ++j) { acc[ai][bj][m][0][j] *= a[j] * __builtin_amdgcn_rcpf(b[j]); acc[ai][bj][m][1][j] *= a[4 + j] * __builtin_amdgcn_rcpf(b[4 + j]); }
                    } else {
                        float v[8];
#pragma unroll
                        for (int j = 0; j < 4; ++j) { v[j] = acc[ai][bj][m][0][j] * b[j]; v[4 + j] = acc[ai][bj][m][1][j] * b[4 + j]; }
                        u32x4 w; w.x = cvt_pk_bf16(v[0], v[1]); w.y = cvt_pk_bf16(v[2], v[3]); w.z = cvt_pk_bf16(v[4], v[5]); w.w = cvt_pk_bf16(v[6], v[7]);
                        *(u32x4*)(MG + (size_t)row * LDH + col0 + bj * HALF) = w;
                    } } }
        return u.sub == 0;
    }
};

struct EpiOut {
    static constexpr bool PERM = false;
    const float* xp; const float* xs; bf16_t* YT; float* SSQ;
    __device__ __forceinline__ bool operator()(Acc& acc, const Unit& u, int wr, int wc, int fr, int fq) const {
        const int row0 = u.pm * BM + wr * 64 + fr, col0 = u.pn * BM + wc * 32 + 4 * fq;
#pragma unroll
        for (int ai = 0; ai < 2; ++ai)
#pragma unroll
            for (int m = 0; m < 4; ++m) { const int row = row0 + ai * HALF + m * 16;
                const float* xr = (row < MP ? xp + (size_t)row * D : xs + (size_t)(row - MP) * D) + col0; float* yr = (float*)(YT + (size_t)row * LDH) + col0; float ss = 0.f;
#pragma unroll
                for (int bj = 0; bj < 2; ++bj)
#pragma unroll
                    for (int n = 0; n < 2; ++n) { const f32x4 y = *(const f32x4*)(xr + bj * HALF + n * 16) + acc[ai][bj][m][n]; *(f32x4*)(yr + bj * HALF + n * 16) = y;
                        ss += (y[0] * y[0] + y[1] * y[1]) + (y[2] * y[2] + y[3] * y[3]); }
                ss += __shfl_xor(ss, 16); ss += __shfl_xor(ss, 32);
                if (fq == 0) SSQ[(size_t)row * 16 + u.pn * 4 + wc] = ss; }
        return false;
    }
};
}

constexpr int NWAVES = 8;
constexpr int N_LAUNCHES = MK_N_LAUNCHES;
constexpr int NPHASE = 8;
constexpr int RING_BYTES = 131072, LDSCTL_OFF = RING_BYTES, MISC_OFF = LDSCTL_OFF + 320, LDS_BYTES = 147456;
constexpr int CW_BAR = 4096, CW_QUEUE = 64;

#define GAS __attribute__((address_space(1)))
#define LAS __attribute__((address_space(3)))
typedef unsigned short bf16;
typedef unsigned v4u __attribute__((ext_vector_type(4)));
typedef float f32x4 __attribute__((ext_vector_type(4)));
typedef GAS unsigned gu32;
#define RLX_AGENT __ATOMIC_RELAXED, __HIP_MEMORY_SCOPE_AGENT
#define LDS_WAIT() asm volatile("s_waitcnt lgkmcnt(0)" ::: "memory")
__device__ __forceinline__ unsigned f2bf(float f) { unsigned u = __builtin_bit_cast(unsigned, f); return (u + 0x7fffu + ((u >> 16) & 1u)) >> 16; }
__device__ __forceinline__ unsigned pk2(float lo, float hi) { return f2bf(lo) | (f2bf(hi) << 16); }
__device__ __forceinline__ float bf2f(bf16 h) { return __uint_as_float((unsigned)h << 16); }
__device__ __forceinline__ float h2f(bf16 h) { return (float)__builtin_bit_cast(_Float16, h); }

#define XB_TMO      128
#define XB_XCNT(j)  (256  + 64 * (j))
#define XB_XSUB(j)  (1280 + 64 * (j))
#define XB_XGEN(j)  (2304 + 64 * (j))
#define XB_TOP      3328
#define XB_TOPGEN   3392
#define XCD_BAR_WORDS 3456
#define XB_SPIN_CAP (1u << 22)
__device__ __forceinline__ unsigned xb_ld(unsigned* p)              { return __hip_atomic_load(p, __ATOMIC_RELAXED, __HIP_MEMORY_SCOPE_AGENT); }
__device__ __forceinline__ unsigned xb_add(unsigned* p, unsigned v) { return __hip_atomic_fetch_add(p, v, __ATOMIC_RELAXED, __HIP_MEMORY_SCOPE_AGENT); }
__device__ __forceinline__ unsigned xb_xcc_id() { return (unsigned)__builtin_amdgcn_s_getreg((3 << 11) | 20) & 0xFu; }
#define XB_SPIN(cond, bar) do { unsigned _sp = 0; while (cond) { __builtin_amdgcn_s_sleep(1); \
    if ((++_sp & 255u) == 0u) { if (xb_ld(&(bar)[XB_TMO])) break; if (_sp > XB_SPIN_CAP) { atomicAdd(&(bar)[XB_TMO], 1u); break; } } } } while (0)
struct XcdBarrier { unsigned* bar; unsigned x; volatile LAS unsigned* st; };
__device__ __forceinline__ XcdBarrier xcd_barrier_post(unsigned* bar, volatile LAS unsigned* st) {
    XcdBarrier b; b.bar = bar; b.x = xb_xcc_id(); b.st = st;
    if (threadIdx.x == 0) (void)xb_add(&bar[XB_XCNT(b.x)], 1u);
    return b;
}
__device__ __forceinline__ void xcd_barrier_complete(unsigned* bar, unsigned x, unsigned& nloc, unsigned& nx) {
    const unsigned G = gridDim.x * gridDim.y * gridDim.z;
    unsigned sum, cnt, mine, sp = 0u;
    for (;;) {
        sum = 0u; cnt = 0u; mine = 0u;
#pragma unroll
        for (unsigned j = 0; j < 16; ++j) { const unsigned c = xb_ld(&bar[XB_XCNT(j)]); sum += c; cnt += (c > 0u) ? 1u : 0u; mine = (j == x) ? c : mine; }
        if (sum == G) break;
        __builtin_amdgcn_s_sleep(1);
        if ((++sp & 255u) == 0u) { if (xb_ld(&bar[XB_TMO])) break; if (sp > XB_SPIN_CAP) { atomicAdd(&bar[XB_TMO], 1u); break; } }
    }
    nloc = mine > 0u ? mine : 1u; nx = cnt > 0u ? cnt : 1u;
}
__device__ __forceinline__ void xcd_barrier(const XcdBarrier& b) {
    asm volatile("s_waitcnt vmcnt(0)" ::: "memory");
    __syncthreads();
    if (threadIdx.x == 0) {
        unsigned* bar = b.bar;
        __builtin_amdgcn_s_waitcnt(0);
        unsigned nloc = b.st[0], nx = b.st[1];
        if (nloc == 0u) { xcd_barrier_complete(bar, b.x, nloc, nx); b.st[0] = nloc; b.st[1] = nx; }
        const unsigned old = xb_add(&bar[XB_XSUB(b.x)], 1u);
        const unsigned gen = old / nloc;
        if (old + 1u == (gen + 1u) * nloc) {
            __builtin_amdgcn_fence(__ATOMIC_RELEASE, "agent");
            asm volatile("s_waitcnt vmcnt(0)" ::: "memory");
            const unsigned og = xb_add(&bar[XB_TOP], 1u);
            const unsigned tg = og / nx;
            if (og + 1u == (tg + 1u) * nx) xb_add(&bar[XB_TOPGEN], 1u);
            else XB_SPIN(xb_ld(&bar[XB_TOPGEN]) == tg, bar);
            __builtin_amdgcn_fence(__ATOMIC_ACQUIRE, "agent");
            xb_add(&bar[XB_XGEN(b.x)], 1u);
            asm volatile("s_waitcnt vmcnt(0)" ::: "memory");
        } else {
            XB_SPIN(xb_ld(&bar[XB_XGEN(b.x)]) == gen, bar);
            __builtin_amdgcn_fence(__ATOMIC_ACQUIRE, "agent");
            asm volatile("s_waitcnt vmcnt(0)" ::: "memory");
        }
    }
    __syncthreads();
}

struct Frame {
    LAS unsigned char* lds;
    int tid, lane, wave, vcu, G;
    const float *xp, *xs, *st_in, *ck_in, *cv_in, *norm_in, *w_in, *lb_logits, *a_gnorm, *b_sinks, *w_pa, *w_pb, *w_out, *norm_final;
    float* out; unsigned char* ws;
    bf16 *Win_t, *Wpa_t, *Wpb_t, *Wout_t, *XN, *H; float *LB, *SSQ, *CKP, *CVP, *CKSN, *CVSN;
};

__device__ __forceinline__ float wave_sum(float v) {
#pragma unroll
    for (int o = 1; o < 64; o <<= 1) v += __shfl_xor(v, o);
    return v;
}

__device__ __forceinline__ void p0_transpose_item(const float* W, int K, int N, bf16* WT, LAS float* scr, int item, int lane) {
    const int nblk = N / 32, kb = item / nblk, nb = item % nblk, k0 = 64 * kb, n0 = 32 * nb;
#pragma unroll 8
    for (int i = 0; i < 32; ++i) { const int kk = 2 * i + (lane >> 5); scr[kk * 33 + (lane & 31)] = W[(size_t)(k0 + kk) * N + n0 + (lane & 31)]; }
    LDS_WAIT(); asm volatile("" ::: "memory");
    const int c = lane & 7;
#pragma unroll
    for (int j = 0; j < 4; ++j) { const int n = (lane >> 3) + 8 * j; const LAS float* s = scr + (8 * c) * 33 + n;
        v4u o; o.x = pk2(s[0 * 33], s[1 * 33]); o.y = pk2(s[2 * 33], s[3 * 33]); o.z = pk2(s[4 * 33], s[5 * 33]); o.w = pk2(s[6 * 33], s[7 * 33]);
        *(GAS v4u*)(WT + (size_t)(n0 + n) * K + k0 + 8 * c) = o; }
    LDS_WAIT(); asm volatile("" ::: "memory");
}
__device__ __forceinline__ void p0_prologue(Frame& F) {
    LAS float* scr = (LAS float*)(F.lds + F.wave * 16384);
    const int gw = F.vcu * NWAVES + F.wave, NGW = F.G * NWAVES;
    constexpr int I_IN = (D / 64) * (NIN / 32), I_SQ = (D / 64) * (D / 32);
    constexpr int NITEMS = I_IN + 3 * I_SQ;
    for (int it = gw; it < NITEMS; it += NGW) {
        int r = it;
        if (r < I_IN) { p0_transpose_item(F.w_in, D, NIN, F.Win_t, scr, r, F.lane); continue; } r -= I_IN;
        if (r < I_SQ) { p0_transpose_item(F.w_pa, D, D, F.Wpa_t, scr, r, F.lane); continue; } r -= I_SQ;
        if (r < I_SQ) { p0_transpose_item(F.w_pb, D, D, F.Wpb_t, scr, r, F.lane); continue; } r -= I_SQ;
        p0_transpose_item(F.w_out, D, D, F.Wout_t, scr, r, F.lane);
    }
    f32x4 gv[4];
#pragma unroll
    for (int j = 0; j < 4; ++j) gv[j] = ((const f32x4*)F.norm_in)[F.lane + 64 * j];
    for (int m = gw; m < M; m += NGW) {
        const float* xrow = m < MP ? F.xp + (size_t)m * D : F.xs + (size_t)(m - MP) * D;
        const f32x4* xr = (const f32x4*)xrow + F.lane;
        f32x4 v[4]; float s = 0.f;
#pragma unroll
        for (int j = 0; j < 4; ++j) { v[j] = xr[64 * j]; s += (v[j].x * v[j].x + v[j].y * v[j].y) + (v[j].z * v[j].z + v[j].w * v[j].w); }
        const float rstd = 1.0f / sqrtf(wave_sum(s) * (1.f / D) + EPS);
        unsigned long long* o8 = (unsigned long long*)(F.XN + (size_t)m * D) + F.lane;
#pragma unroll
        for (int j = 0; j < 4; ++j) o8[64 * j] = (unsigned long long)pk2(v[j].x * rstd * gv[j].x, v[j].y * rstd * gv[j].y) | ((unsigned long long)pk2(v[j].z * rstd * gv[j].z, v[j].w * rstd * gv[j].w) << 32);
    }
    { const int gt = F.vcu * 512 + F.tid; if (gt < D) { const float l0 = F.lb_logits[gt], l1 = F.lb_logits[D + gt]; F.LB[gt] = 1.0f / (1.0f + expf(l1 - l0)); } }
}

namespace hg {
typedef short bf16x8 __attribute__((ext_vector_type(8)));
typedef float f32x16 __attribute__((ext_vector_type(16)));
typedef float f32x4 __attribute__((ext_vector_type(4)));
typedef float f32x2 __attribute__((ext_vector_type(2)));
typedef unsigned u32x4 __attribute__((ext_vector_type(4)));
typedef unsigned u32x2 __attribute__((ext_vector_type(2)));
constexpr int L_QI = 0, L_KI = 16384, L_KT = 32768, L_VT = 49152, L_SPT = 65536, L_OS = 98304, L_SEG = 114688, L_ER = 118784, L_EB = 119296, L_RS = 119808, L_GN = 120832;
#define HG_MFMA(a, b, c) __builtin_amdgcn_mfma_f32_32x32x16_bf16((a), (b), (c), 0, 0, 0)
__device__ __forceinline__ int img256(int row, int k) { return row * 256 + ((((k >> 3) ^ (row & 15))) << 4) + (k & 7) * 2; }
__device__ __forceinline__ int img128(int row, int s) { return row * 128 + ((((s >> 3) ^ ((row >> 1) & 7))) << 4) + (s & 7) * 2; }
__device__ __forceinline__ int crow(int r, int h) { return (r & 3) + 8 * (r >> 2) + 4 * h; }
__device__ __forceinline__ float ex2(float x) { return __builtin_amdgcn_exp2f(x); }
__device__ __forceinline__ unsigned pkbf(float lo, float hi) { return pg8::cvt_pk_bf16(lo, hi); }
__device__ __forceinline__ float h_lo(unsigned w) { typedef _Float16 h2 __attribute__((ext_vector_type(2))); return (float)__builtin_bit_cast(h2, w).x; }
__device__ __forceinline__ float h_hi(unsigned w) { typedef _Float16 h2 __attribute__((ext_vector_type(2))); return (float)__builtin_bit_cast(h2, w).y; }

template <bool OUT>
__device__ __forceinline__ void hgrn_item(Frame& F, int b, int h, int sc) {
    LAS unsigned char* L = F.lds;
    int tid = F.tid; asm volatile("" : "+v"(tid));
    const int lane = tid & 63, w = F.wave, hh = lane >> 5, r32 = lane & 31;
    const int kp = lane, ts = w, tb = w & 1, vb = w >> 1, kb0 = 2 * (w & 1);
    const size_t rowb = (size_t)b * SEQ + (size_t)sc * 1024;
    float* Ubase = (float*)(F.ws + WS_HU) + (size_t)(b * 8 + h) * 3 * 16384;
    float* Dbase = (float*)(F.ws + WS_HD) + (size_t)(b * 8 + h) * 3 * 128;
    f32x16 St[2];
#pragma unroll
    for (int i = 0; i < 2; ++i)
#pragma unroll
        for (int r = 0; r < 16; ++r) St[i][r] = 0.f;
    if (OUT) {
        for (int j = 0; j < sc; ++j) {
            const float* U = Ubase + (size_t)j * 16384; const float* Dt = Dbase + j * 128;
#pragma unroll
            for (int i = 0; i < 2; ++i)
#pragma unroll
                for (int g = 0; g < 4; ++g) { const int k0 = (kb0 + i) * 32 + 8 * g + 4 * hh; const f32x4 d = *(const f32x4*)(Dt + k0);
#pragma unroll
                    for (int jj = 0; jj < 4; ++jj) St[i][4 * g + jj] = d[jj] * St[i][4 * g + jj] + U[(size_t)(k0 + jj) * 128 + vb * 32 + r32]; }
        }
    }
    float gsum0 = 0.f, gsum1 = 0.f;
    const int colq = HC_QA + h * 128 + 2 * kp, colg = HC_G2 + h * 128 + 2 * kp, colv = HC_VA + h * 128 + 2 * kp;
    unsigned gw[8], qw[8], vw[8];
#pragma unroll
    for (int j = 0; j < 8; ++j) { const bf16* hr = F.H + (rowb + 8 * ts + j) * LDH; gw[j] = *(const unsigned*)(hr + colg); vw[j] = *(const unsigned*)(hr + colv); if (OUT) qw[j] = *(const unsigned*)(hr + colq); else qw[j] = 0u; }
    if (OUT && tid < 128) *(LAS float*)(L + L_GN + tid * 4) = F.a_gnorm[tid];
    for (int c = 0; c < 16; ++c) {
        const size_t row0 = rowb + (size_t)c * 64;
        u32x4 zpre[2];
        if (OUT) {
#pragma unroll
            for (int i = 0; i < 2; ++i) zpre[i] = *(const u32x4*)(F.H + (row0 + (tid >> 3)) * LDH + HC_ZA + h * 128 + 8 * ((tid & 7) * 2 + i));
        }
        float c0[8], c1[8];
        { float a0 = 0.f, a1 = 0.f;
#pragma unroll
          for (int j = 0; j < 8; ++j) { a0 += h_lo(gw[j]); a1 += h_hi(gw[j]); c0[j] = a0; c1[j] = a1; }
          *(LAS f32x2*)(L + L_SEG + (ts * 128 + 2 * kp) * 4) = (f32x2){a0, a1}; }
        __syncthreads();
        float off0 = 0.f, off1 = 0.f, rho0 = 0.f, rho1 = 0.f, bl0 = 0.f, bl1 = 0.f;
#pragma unroll
        for (int s = 0; s < 8; ++s) { const f32x2 sg = *(const LAS f32x2*)(L + L_SEG + (s * 128 + 2 * kp) * 4);
            if (s < ts) { off0 += sg.x; off1 += sg.y; } if (s < 4) { rho0 += sg.x; rho1 += sg.y; } bl0 += sg.x; bl1 += sg.y; }
        if (ts == 0) { *(LAS f32x2*)(L + L_ER + 2 * kp * 4) = (f32x2){ex2(rho0), ex2(rho1)}; *(LAS f32x2*)(L + L_EB + 2 * kp * 4) = (f32x2){ex2(bl0 - rho0), ex2(bl1 - rho1)}; gsum0 += bl0; gsum1 += bl1; }
        { unsigned kt0[4], kt1[4], vt0[4], vt1[4];
#pragma unroll
          for (int j = 0; j < 8; j += 2) {
              float kv0[2], kv1[2];
#pragma unroll
              for (int jj = 0; jj < 2; ++jj) { const int t = 8 * ts + j + jj; const float b0 = off0 + c0[j + jj], b1 = off1 + c1[j + jj];
                  const float k0 = (1.0f - ex2(h_lo(gw[j + jj]))) * ex2(fminf(rho0 - b0, 100.f)), k1 = (1.0f - ex2(h_hi(gw[j + jj]))) * ex2(fminf(rho1 - b1, 100.f));
                  kv0[jj] = k0; kv1[jj] = k1;
                  *(LAS unsigned*)(L + L_KI + img256(t, 2 * kp)) = pkbf(k0, k1);
                  if (OUT) { const float q0 = pg8::bf_lo(qw[j + jj]) * ex2(fminf(b0 - rho0, 100.f)), q1 = pg8::bf_hi(qw[j + jj]) * ex2(fminf(b1 - rho1, 100.f));
                      *(LAS unsigned*)(L + L_QI + img256(t, 2 * kp)) = pkbf(q0, q1); } }
              kt0[j >> 1] = pkbf(kv0[0], kv0[1]); kt1[j >> 1] = pkbf(kv1[0], kv1[1]);
              vt0[j >> 1] = (vw[j] & 0xffffu) | (vw[j + 1] << 16); vt1[j >> 1] = (vw[j] >> 16) | (vw[j + 1] & 0xffff0000u); }
          *(LAS u32x4*)(L + L_KT + img128(2 * kp, 8 * ts)) = (u32x4){kt0[0], kt0[1], kt0[2], kt0[3]}; *(LAS u32x4*)(L + L_KT + img128(2 * kp + 1, 8 * ts)) = (u32x4){kt1[0], kt1[1], kt1[2], kt1[3]};
          *(LAS u32x4*)(L + L_VT + img128(2 * kp, 8 * ts)) = (u32x4){vt0[0], vt0[1], vt0[2], vt0[3]}; *(LAS u32x4*)(L + L_VT + img128(2 * kp + 1, 8 * ts)) = (u32x4){vt1[0], vt1[1], vt1[2], vt1[3]}; }
        if (c + 1 < 16) {
#pragma unroll
            for (int j = 0; j < 8; ++j) { const bf16* hr = F.H + (row0 + 64 + 8 * ts + j) * LDH; gw[j] = *(const unsigned*)(hr + colg); vw[j] = *(const unsigned*)(hr + colv); if (OUT) qw[j] = *(const unsigned*)(hr + colq); }
        }
        __syncthreads();
#pragma unroll
        for (int i = 0; i < 2; ++i)
#pragma unroll
            for (int g = 0; g < 4; ++g) { const int k0 = (kb0 + i) * 32 + 8 * g + 4 * hh; const f32x4 er = *(const LAS f32x4*)(L + L_ER + k0 * 4);
#pragma unroll
                for (int jj = 0; jj < 4; ++jj) St[i][4 * g + jj] *= er[jj];
                if (OUT) *(LAS u32x2*)(L + L_SPT + img256(vb * 32 + r32, k0)) = (u32x2){pkbf(St[i][4 * g], St[i][4 * g + 1]), pkbf(St[i][4 * g + 2], St[i][4 * g + 3])}; }
        __syncthreads();
        f32x16 o;
        if (OUT) {
#pragma unroll
            for (int r = 0; r < 16; ++r) o[r] = 0.f;
#pragma unroll
            for (int sb = 0; sb < 2; ++sb) {
                if (sb <= tb) {
                    f32x16 X;
#pragma unroll
                    for (int r = 0; r < 16; ++r) X[r] = 0.f;
#pragma unroll
                    for (int ks = 0; ks < 8; ++ks) { const bf16x8 a = *(const LAS bf16x8*)(L + L_KI + img256(sb * 32 + r32, 16 * ks + 8 * hh)), qf = *(const LAS bf16x8*)(L + L_QI + img256(tb * 32 + r32, 16 * ks + 8 * hh)); X = HG_MFMA(a, qf, X); }
                    if (sb == tb) {
#pragma unroll
                        for (int r = 0; r < 16; ++r) X[r] = (crow(r, hh) <= r32) ? X[r] : 0.f;
                    }
#pragma unroll
                    for (int k2 = 0; k2 < 2; ++k2) {
                        const u32x4 xs = (u32x4){pkbf(X[8 * k2], X[8 * k2 + 1]), pkbf(X[8 * k2 + 2], X[8 * k2 + 3]), pkbf(X[8 * k2 + 4], X[8 * k2 + 5]), pkbf(X[8 * k2 + 6], X[8 * k2 + 7])};
                        const int s0 = sb * 32 + 16 * k2 + 4 * hh;
                        const u32x2 va = *(const LAS u32x2*)(L + L_VT + img128(vb * 32 + r32, s0)), vbb = *(const LAS u32x2*)(L + L_VT + img128(vb * 32 + r32, s0 + 8));
                        const u32x4 vv = (u32x4){va.x, va.y, vbb.x, vbb.y};
                        o = HG_MFMA(__builtin_bit_cast(bf16x8, vv), __builtin_bit_cast(bf16x8, xs), o);
                    }
                }
            }
#pragma unroll
            for (int ks = 0; ks < 8; ++ks) { const bf16x8 a = *(const LAS bf16x8*)(L + L_SPT + img256(vb * 32 + r32, 16 * ks + 8 * hh)), qf = *(const LAS bf16x8*)(L + L_QI + img256(tb * 32 + r32, 16 * ks + 8 * hh)); o = HG_MFMA(a, qf, o); }
        }
#pragma unroll
        for (int i = 0; i < 2; ++i) {
#pragma unroll
            for (int ks = 0; ks < 4; ++ks) { const bf16x8 a = *(const LAS bf16x8*)(L + L_KT + img128((kb0 + i) * 32 + r32, 16 * ks + 8 * hh)), bq = *(const LAS bf16x8*)(L + L_VT + img128(vb * 32 + r32, 16 * ks + 8 * hh));
                St[i] = HG_MFMA(a, bq, St[i]); }
#pragma unroll
            for (int g = 0; g < 4; ++g) { const int k0 = (kb0 + i) * 32 + 8 * g + 4 * hh; const f32x4 eb = *(const LAS f32x4*)(L + L_EB + k0 * 4);
#pragma unroll
                for (int jj = 0; jj < 4; ++jj) St[i][4 * g + jj] *= eb[jj]; }
        }
        if (OUT) {
            float ss = 0.f;
#pragma unroll
            for (int r = 0; r < 16; ++r) ss += o[r] * o[r];
            ss += __shfl_xor(ss, 32);
            if (hh == 0) *(LAS float*)(L + L_RS + ((tb * 4 + vb) * 32 + r32) * 4) = ss;
            __syncthreads();
            float tot = 0.f;
#pragma unroll
            for (int v2 = 0; v2 < 4; ++v2) tot += *(const LAS float*)(L + L_RS + ((tb * 4 + v2) * 32 + r32) * 4);
            const float rn = 1.0f / sqrtf(tot * (1.f / 128.f) + EPS);
#pragma unroll
            for (int g = 0; g < 4; ++g) *(LAS u32x2*)(L + L_OS + img256(tb * 32 + r32, vb * 32 + 8 * g + 4 * hh)) = (u32x2){pkbf(o[4 * g] * rn, o[4 * g + 1] * rn), pkbf(o[4 * g + 2] * rn, o[4 * g + 3] * rn)};
            __syncthreads();
#pragma unroll
            for (int i = 0; i < 2; ++i) { const int t = tid >> 3, cc = (tid & 7) * 2 + i;
                const u32x4 o8 = *(const LAS u32x4*)(L + L_OS + img256(t, 8 * cc));
                bf16* hr = F.H + (row0 + t) * LDH; const u32x4 z8 = zpre[i];
                const f32x4 g0 = *(const LAS f32x4*)(L + L_GN + 32 * cc), g1 = *(const LAS f32x4*)(L + L_GN + 32 * cc + 16);
                u32x4 r;
                r.x = pkbf(pg8::bf_lo(o8.x) * g0[0] * pg8::bf_lo(z8.x), pg8::bf_hi(o8.x) * g0[1] * pg8::bf_hi(z8.x)); r.y = pkbf(pg8::bf_lo(o8.y) * g0[2] * pg8::bf_lo(z8.y), pg8::bf_hi(o8.y) * g0[3] * pg8::bf_hi(z8.y));
                r.z = pkbf(pg8::bf_lo(o8.z) * g1[0] * pg8::bf_lo(z8.z), pg8::bf_hi(o8.z) * g1[1] * pg8::bf_hi(z8.z)); r.w = pkbf(pg8::bf_lo(o8.w) * g1[2] * pg8::bf_lo(z8.w), pg8::bf_hi(o8.w) * g1[3] * pg8::bf_hi(z8.w));
                *(u32x4*)(hr + HC_HA + h * 128 + 8 * cc) = r; }
        } else {
            __syncthreads();
        }
    }
    if (OUT) {
        if (sc == 3) {
            float* so = F.out + O_SP + (size_t)(b * 8 + h) * 16384;
#pragma unroll
            for (int i = 0; i < 2; ++i)
#pragma unroll
                for (int r = 0; r < 16; ++r) so[(size_t)((kb0 + i) * 32 + crow(r, hh)) * 128 + vb * 32 + r32] = St[i][r];
        }
    } else {
        float* U = Ubase + (size_t)sc * 16384;
#pragma unroll
        for (int i = 0; i < 2; ++i)
#pragma unroll
            for (int r = 0; r < 16; ++r) U[(size_t)((kb0 + i) * 32 + crow(r, hh)) * 128 + vb * 32 + r32] = St[i][r];
        if (ts == 0) *(f32x2*)(Dbase + sc * 128 + 2 * kp) = (f32x2){ex2(gsum0), ex2(gsum1)};
    }
    __syncthreads();
}
#undef HG_MFMA
}


namespace sw {
typedef short bf16x8 __attribute__((ext_vector_type(8)));
typedef float f32x16 __attribute__((ext_vector_type(16)));
typedef unsigned u32x4 __attribute__((ext_vector_type(4)));
typedef unsigned u32x2 __attribute__((ext_vector_type(2)));
constexpr int L_K = 0, L_VT = 32768, L_OST = 65536;
#define SW_MFMA(a, b, c) __builtin_amdgcn_mfma_f32_32x32x16_bf16((a), (b), (c), 0, 0, 0)
__device__ __forceinline__ int img_k(int row, int d) { return row * 128 + ((((d >> 3) ^ ((row >> 1) & 7))) << 4) + (d & 7) * 2; }
__device__ __forceinline__ int img_vt(int row, int key) { return row * 512 + ((((key >> 3) ^ (row & 31))) << 4) + (key & 7) * 2; }
__device__ __forceinline__ int crow(int r, int h) { return (r & 3) + 8 * (r >> 2) + 4 * h; }

__device__ __forceinline__ void swa_unit(Frame& F, int b, int qb, int kvh) {
    LAS unsigned char* L = F.lds;
    int tid = F.tid; asm volatile("" : "+v"(tid));
    const int lane = tid & 63, g = F.wave, hh_ = lane >> 5, r32_ = lane & 31;
    const long key_row0 = (long)b * SEQ + (long)(qb - 1) * 128;
    const int k_first = qb == 0 ? 128 : 0;
#pragma unroll
    for (int i = 0; i < 4; ++i) { const int idx = tid + 512 * i, key = idx >> 3, ch = idx & 7;
        if (key >= k_first) *(LAS u32x4*)(L + L_K + img_k(key, 8 * ch)) = *(const u32x4*)(F.H + (size_t)(key_row0 + key) * LDH + HC_KB + kvh * 64 + 8 * ch); }
    { const int dp = tid & 31, kg = tid >> 5;
      if (16 * kg >= k_first) {
          unsigned vw[16];
#pragma unroll
          for (int j = 0; j < 16; ++j) vw[j] = *(const unsigned*)(F.H + (size_t)(key_row0 + 16 * kg + j) * LDH + HC_VB + kvh * 64 + 2 * dp);
#pragma unroll
          for (int hf = 0; hf < 2; ++hf) { u32x4 lo, hi;
#pragma unroll
              for (int p = 0; p < 4; ++p) { const unsigned a = vw[8 * hf + 2 * p], c = vw[8 * hf + 2 * p + 1]; lo[p] = (a & 0xffffu) | (c << 16); hi[p] = (a >> 16) | (c & 0xffff0000u); }
              *(LAS u32x4*)(L + L_VT + img_vt(2 * dp, 16 * kg + 8 * hf)) = lo; *(LAS u32x4*)(L + L_VT + img_vt(2 * dp + 1, 16 * kg + 8 * hf)) = hi; }
      } }
    __syncthreads();
    const int head = kvh * 8 + g;
    const float slope2 = __builtin_amdgcn_exp2f(-0.5f * (float)(head + 1)) * LOG2E, sink2 = F.b_sinks[head] * LOG2E;
    LAS unsigned char* ost = L + L_OST + g * 4096;
    bf16x8 qn[4];
#pragma unroll
    for (int ks = 0; ks < 4; ++ks) qn[ks] = *(const bf16x8*)(F.H + ((size_t)b * SEQ + (size_t)qb * 128 + r32_) * LDH + HC_QB + head * 64 + 16 * ks + 8 * hh_);
#pragma unroll 1
    for (int i = 0; i < 4; ++i) {
        int hh = hh_, r32 = r32_;
        asm volatile("" : "+v"(hh), "+v"(r32));
        const size_t tok0 = (size_t)b * SEQ + (size_t)qb * 128 + 32 * i;
        bf16x8 qf[4];
#pragma unroll
        for (int ks = 0; ks < 4; ++ks) qf[ks] = qn[ks];
        if (i < 3) {
#pragma unroll
            for (int ks = 0; ks < 4; ++ks) qn[ks] = *(const bf16x8*)(F.H + (tok0 + 32 + r32) * LDH + HC_QB + head * 64 + 16 * ks + 8 * hh);
        }
        u32x4 zpre[4];
#pragma unroll
        for (int i4 = 0; i4 < 4; ++i4) { const int idx = lane + 64 * i4; zpre[i4] = *(const u32x4*)(F.H + (tok0 + (idx >> 3)) * LDH + HC_ZB + head * 64 + 8 * (idx & 7)); }
        f32x16 X[5];
        float m = sink2;
#pragma unroll
        for (int j = 0; j < 5; ++j) {
            const int kt = i + j;
            if (32 * kt >= k_first) {
                const float tq = slope2 * (float)(32 * j - 128 - r32);
#pragma unroll
                for (int r = 0; r < 16; ++r) { float c0 = slope2 * (float)crow(r, hh) + tq;
                    if (j == 0) c0 = (crow(r, hh) > r32) ? c0 : -INFINITY;
                    if (j == 4) c0 = (crow(r, hh) <= r32) ? c0 : -INFINITY;
                    X[j][r] = c0; }
#pragma unroll
                for (int ks = 0; ks < 4; ++ks) { const bf16x8 a = *(const LAS bf16x8*)(L + L_K + img_k(32 * kt + r32, 16 * ks + 8 * hh)); X[j] = SW_MFMA(a, qf[ks], X[j]); }
#pragma unroll
                for (int r = 0; r < 16; ++r) m = fmaxf(m, X[j][r]);
                __builtin_amdgcn_sched_barrier(0);
            } else {
#pragma unroll
                for (int r = 0; r < 16; ++r) X[j][r] = -INFINITY;
            }
        }
        m = fmaxf(m, __shfl_xor(m, 32));
        float l = 0.f;
#pragma unroll
        for (int j = 0; j < 5; ++j)
#pragma unroll
            for (int r = 0; r < 16; ++r) { const float p = __builtin_amdgcn_exp2f(X[j][r] - m); X[j][r] = p; l += p; }
        l += __shfl_xor(l, 32); l += __builtin_amdgcn_exp2f(sink2 - m);
        f32x16 o[2];
#pragma unroll
        for (int dt = 0; dt < 2; ++dt)
#pragma unroll
            for (int r = 0; r < 16; ++r) o[dt][r] = 0.f;
#pragma unroll
        for (int j = 0; j < 5; ++j) {
            const int kt = i + j;
            if (32 * kt >= k_first) {
#pragma unroll
                for (int k2 = 0; k2 < 2; ++k2) {
                    const u32x4 xs = (u32x4){pg8::cvt_pk_bf16(X[j][8 * k2], X[j][8 * k2 + 1]), pg8::cvt_pk_bf16(X[j][8 * k2 + 2], X[j][8 * k2 + 3]), pg8::cvt_pk_bf16(X[j][8 * k2 + 4], X[j][8 * k2 + 5]), pg8::cvt_pk_bf16(X[j][8 * k2 + 6], X[j][8 * k2 + 7])};
                    const int key0 = 32 * kt + 16 * k2 + 4 * hh;
#pragma unroll
                    for (int dt = 0; dt < 2; ++dt) {
                        const u32x2 va = *(const LAS u32x2*)(L + L_VT + img_vt(dt * 32 + r32, key0)), vb2 = *(const LAS u32x2*)(L + L_VT + img_vt(dt * 32 + r32, key0 + 8));
                        const u32x4 vv = (u32x4){va.x, va.y, vb2.x, vb2.y};
                        o[dt] = SW_MFMA(__builtin_bit_cast(bf16x8, vv), __builtin_bit_cast(bf16x8, xs), o[dt]);
                    }
                    __builtin_amdgcn_sched_barrier(0);
                }
            }
        }
        const float rl = 1.0f / l;
#pragma unroll
        for (int dt = 0; dt < 2; ++dt)
#pragma unroll
            for (int g4 = 0; g4 < 4; ++g4) *(LAS u32x2*)(ost + img_k(r32, dt * 32 + 8 * g4 + 4 * hh)) = (u32x2){pg8::cvt_pk_bf16(o[dt][4 * g4] * rl, o[dt][4 * g4 + 1] * rl), pg8::cvt_pk_bf16(o[dt][4 * g4 + 2] * rl, o[dt][4 * g4 + 3] * rl)};
#pragma unroll
        for (int i4 = 0; i4 < 4; ++i4) { const int idx = lane + 64 * i4, q = idx >> 3, ch = idx & 7;
            const u32x4 o8 = *(const LAS u32x4*)(ost + img_k(q, 8 * ch));
            bf16* hr = F.H + (tok0 + q) * LDH; const u32x4 z8 = zpre[i4];
            u32x4 rr;
            rr.x = pg8::cvt_pk_bf16(pg8::bf_lo(o8.x) * pg8::bf_lo(z8.x), pg8::bf_hi(o8.x) * pg8::bf_hi(z8.x)); rr.y = pg8::cvt_pk_bf16(pg8::bf_lo(o8.y) * pg8::bf_lo(z8.y), pg8::bf_hi(o8.y) * pg8::bf_hi(z8.y));
            rr.z = pg8::cvt_pk_bf16(pg8::bf_lo(o8.z) * pg8::bf_lo(z8.z), pg8::bf_hi(o8.z) * pg8::bf_hi(z8.z)); rr.w = pg8::cvt_pk_bf16(pg8::bf_lo(o8.w) * pg8::bf_lo(z8.w), pg8::bf_hi(o8.w) * pg8::bf_hi(z8.w));
            *(u32x4*)(hr + HC_HB + head * 64 + 8 * ch) = rr; }
    }
    __syncthreads();
}
#undef SW_MFMA
}


namespace smp {
typedef short bf16x8 __attribute__((ext_vector_type(8)));
typedef float f32x16 __attribute__((ext_vector_type(16)));
typedef float f32x4 __attribute__((ext_vector_type(4)));
typedef unsigned u32x4 __attribute__((ext_vector_type(4)));
typedef unsigned u32x2 __attribute__((ext_vector_type(2)));
#define SM_MFMA(a, b, c) __builtin_amdgcn_mfma_f32_32x32x16_bf16((a), (b), (c), 0, 0, 0)
__device__ __forceinline__ void swa_sample_unit(Frame& F, int db, int kvh) {
    LAS unsigned char* L = F.lds;
    int tid = F.tid; asm volatile("" : "+v"(tid));
    const int lane = tid & 63;
    for (int idx = tid; idx < 160 * 8; idx += 512) { const int key = idx >> 3, ch = idx & 7; u32x4 w;
        if (key < 128) { const float* kp = F.ck_in + ((size_t)(db * 128 + key) * 2 + kvh) * 64 + 8 * ch; const f32x4 a = *(const f32x4*)kp, c = *(const f32x4*)(kp + 4);
            w = (u32x4){pg8::cvt_pk_bf16(a[0], a[1]), pg8::cvt_pk_bf16(a[2], a[3]), pg8::cvt_pk_bf16(c[0], c[1]), pg8::cvt_pk_bf16(c[2], c[3])}; }
        else if (key < 132) w = *(const u32x4*)(F.H + (size_t)(MP + db * 4 + key - 128) * LDH + HC_KB + kvh * 64 + 8 * ch);
        else w = (u32x4){0u, 0u, 0u, 0u};
        *(LAS u32x4*)(L + sw::L_K + sw::img_k(key, 8 * ch)) = w; }
    { const int dp = tid & 31, kg = tid >> 5;
      if (kg < 10) {
          float v0[16], v1[16];
#pragma unroll
          for (int j = 0; j < 16; ++j) { const int key = 16 * kg + j;
              if (key < 128) { const float2 a = *(const float2*)(F.cv_in + ((size_t)(db * 128 + key) * 2 + kvh) * 64 + 2 * dp); v0[j] = a.x; v1[j] = a.y; }
              else if (key < 132) { const unsigned a = *(const unsigned*)(F.H + (size_t)(MP + db * 4 + key - 128) * LDH + HC_VB + kvh * 64 + 2 * dp); v0[j] = pg8::bf_lo(a); v1[j] = pg8::bf_hi(a); }
              else { v0[j] = 0.f; v1[j] = 0.f; } }
#pragma unroll
          for (int hf = 0; hf < 2; ++hf) { u32x4 lo, hi;
#pragma unroll
              for (int p = 0; p < 4; ++p) { lo[p] = pg8::cvt_pk_bf16(v0[8 * hf + 2 * p], v0[8 * hf + 2 * p + 1]); hi[p] = pg8::cvt_pk_bf16(v1[8 * hf + 2 * p], v1[8 * hf + 2 * p + 1]); }
              *(LAS u32x4*)(L + sw::L_VT + sw::img_vt(2 * dp, 16 * kg + 8 * hf)) = lo; *(LAS u32x4*)(L + sw::L_VT + sw::img_vt(2 * dp + 1, 16 * kg + 8 * hf)) = hi; }
      } }
    __syncthreads();
    if (F.wave == 0) {
        const int hh = lane >> 5, r32 = lane & 31, t = r32 >> 3, head = kvh * 8 + (r32 & 7);
        const float slope2 = __builtin_amdgcn_exp2f(-0.5f * (float)(head + 1)) * LOG2E, sink2 = F.b_sinks[head] * LOG2E;
        const size_t qrow = (size_t)(MP + db * 4 + t);
        bf16x8 qf[4];
#pragma unroll
        for (int ks = 0; ks < 4; ++ks) qf[ks] = *(const bf16x8*)(F.H + qrow * LDH + HC_QB + head * 64 + 16 * ks + 8 * hh);
        f32x16 X[5];
        float m = sink2;
#pragma unroll
        for (int j = 0; j < 5; ++j) {
#pragma unroll
            for (int r = 0; r < 16; ++r) { const int kj = 32 * j + sw::crow(r, hh); X[j][r] = (kj > t && kj <= 128 + t) ? slope2 * (float)(kj - 128 - t) : -INFINITY; }
#pragma unroll
            for (int ks = 0; ks < 4; ++ks) { const bf16x8 a = *(const LAS bf16x8*)(L + sw::L_K + sw::img_k(32 * j + r32, 16 * ks + 8 * hh)); X[j] = SM_MFMA(a, qf[ks], X[j]); }
#pragma unroll
            for (int r = 0; r < 16; ++r) m = fmaxf(m, X[j][r]);
        }
        m = fmaxf(m, __shfl_xor(m, 32));
        float l = 0.f;
#pragma unroll
        for (int j = 0; j < 5; ++j)
#pragma unroll
            for (int r = 0; r < 16; ++r) { const float p = __builtin_amdgcn_exp2f(X[j][r] - m); X[j][r] = p; l += p; }
        l += __shfl_xor(l, 32); l += __builtin_amdgcn_exp2f(sink2 - m);
        f32x16 o[2];
#pragma unroll
        for (int dt = 0; dt < 2; ++dt)
#pragma unroll
            for (int r = 0; r < 16; ++r) o[dt][r] = 0.f;
#pragma unroll
        for (int j = 0; j < 5; ++j)
#pragma unroll
            for (int k2 = 0; k2 < 2; ++k2) {
                const u32x4 xs = (u32x4){pg8::cvt_pk_bf16(X[j][8 * k2], X[j][8 * k2 + 1]), pg8::cvt_pk_bf16(X[j][8 * k2 + 2], X[j][8 * k2 + 3]), pg8::cvt_pk_bf16(X[j][8 * k2 + 4], X[j][8 * k2 + 5]), pg8::cvt_pk_bf16(X[j][8 * k2 + 6], X[j][8 * k2 + 7])};
                const int key0 = 32 * j + 16 * k2 + 4 * hh;
#pragma unroll
                for (int dt = 0; dt < 2; ++dt) {
                    const u32x2 va = *(const LAS u32x2*)(L + sw::L_VT + sw::img_vt(dt * 32 + r32, key0)), vb2 = *(const LAS u32x2*)(L + sw::L_VT + sw::img_vt(dt * 32 + r32, key0 + 8));
                    const u32x4 vv = (u32x4){va.x, va.y, vb2.x, vb2.y};
                    o[dt] = SM_MFMA(__builtin_bit_cast(bf16x8, vv), __builtin_bit_cast(bf16x8, xs), o[dt]);
                }
            }
        const float rl = 1.0f / l;
        LAS unsigned char* ost = L + sw::L_OST;
#pragma unroll
        for (int dt = 0; dt < 2; ++dt)
#pragma unroll
            for (int g4 = 0; g4 < 4; ++g4) *(LAS u32x2*)(ost + sw::img_k(r32, dt * 32 + 8 * g4 + 4 * hh)) = (u32x2){pg8::cvt_pk_bf16(o[dt][4 * g4] * rl, o[dt][4 * g4 + 1] * rl), pg8::cvt_pk_bf16(o[dt][4 * g4 + 2] * rl, o[dt][4 * g4 + 3] * rl)};
#pragma unroll
        for (int i4 = 0; i4 < 4; ++i4) { const int idx = lane + 64 * i4, q = idx >> 3, ch = idx & 7;
            const u32x4 o8 = *(const LAS u32x4*)(ost + sw::img_k(q, 8 * ch));
            bf16* hr = F.H + (size_t)(MP + db * 4 + (q >> 3)) * LDH; const int hd = kvh * 8 + (q & 7); const u32x4 z8 = *(const u32x4*)(hr + HC_ZB + hd * 64 + 8 * ch);
            u32x4 rr;
            rr.x = pg8::cvt_pk_bf16(pg8::bf_lo(o8.x) * pg8::bf_lo(z8.x), pg8::bf_hi(o8.x) * pg8::bf_hi(z8.x)); rr.y = pg8::cvt_pk_bf16(pg8::bf_lo(o8.y) * pg8::bf_lo(z8.y), pg8::bf_hi(o8.y) * pg8::bf_hi(z8.y));
            rr.z = pg8::cvt_pk_bf16(pg8::bf_lo(o8.z) * pg8::bf_lo(z8.z), pg8::bf_hi(o8.z) * pg8::bf_hi(z8.z)); rr.w = pg8::cvt_pk_bf16(pg8::bf_lo(o8.w) * pg8::bf_lo(z8.w), pg8::bf_hi(o8.w) * pg8::bf_hi(z8.w));
            *(u32x4*)(hr + HC_HB + hd * 64 + 8 * ch) = rr; }
    }
    __syncthreads();
}
#undef SM_MFMA

__device__ __forceinline__ void hgrn_sample_item(Frame& F, int db, int h) {
    LAS float* CO = (LAS float*)F.lds; LAS float* ATT = CO + 9 * 128; LAS float* VV = ATT + 64; LAS float* PART = VV + 512; LAS float* RED = PART + 16 * 512; LAS float* AP = RED + 16;
    int tid = F.tid; asm volatile("" : "+v"(tid));
    const int lane = tid & 63;
    const size_t row0 = (size_t)MP + db * 4;
    if (tid < 128) {
        const int k = tid; float q[4], kk[4], bb[4]; float acc = 0.f;
#pragma unroll
        for (int t = 0; t < 4; ++t) { const bf16* hr = F.H + (row0 + t) * LDH; q[t] = bf2f(hr[HC_QA + h * 128 + k]); const float g2 = h2f(hr[HC_G2 + h * 128 + k]); acc += g2; bb[t] = acc; kk[t] = 1.0f - __builtin_amdgcn_exp2f(g2);
            VV[t * 128 + k] = bf2f(hr[HC_VA + h * 128 + k]); }
#pragma unroll
        for (int t = 0; t < 4; ++t) { CO[t * 128 + k] = q[t] * __builtin_amdgcn_exp2f(bb[t]); CO[(4 + t) * 128 + k] = kk[t] * __builtin_amdgcn_exp2f(bb[3] - bb[t]); }
        CO[8 * 128 + k] = __builtin_amdgcn_exp2f(bb[3]);
        float a[10]; int n = 0;
#pragma unroll
        for (int t = 0; t < 4; ++t)
#pragma unroll
            for (int s = 0; s <= t; ++s) a[n++] = q[t] * kk[s] * __builtin_amdgcn_exp2f(bb[t] - bb[s]);
#pragma unroll
        for (int i = 0; i < 10; ++i) { const float r = wave_sum(a[i]); if (lane == 0) AP[F.wave * 16 + i] = r; }
    }
    const int v4 = tid & 31, kq = tid >> 5;
    const float* Sin = F.st_in + ((size_t)(db * 8 + h) * 128 + 8 * kq) * 128 + 4 * v4; float* Sout = F.out + O_SS + ((size_t)(db * 8 + h) * 128 + 8 * kq) * 128 + 4 * v4;
    f32x4 S[8];
#pragma unroll
    for (int j = 0; j < 8; ++j) S[j] = *(const f32x4*)(Sin + (size_t)j * 128);
    __syncthreads();
    f32x4 vs[4];
#pragma unroll
    for (int s = 0; s < 4; ++s) vs[s] = *(const LAS f32x4*)(VV + s * 128 + 4 * v4);
    f32x4 op[4];
#pragma unroll
    for (int t = 0; t < 4; ++t) op[t] = (f32x4){0.f, 0.f, 0.f, 0.f};
#pragma unroll
    for (int j = 0; j < 8; ++j) { const int k = 8 * kq + j;
#pragma unroll
        for (int t = 0; t < 4; ++t) op[t] += S[j] * CO[t * 128 + k];
        f32x4 sn = S[j] * CO[8 * 128 + k];
#pragma unroll
        for (int s = 0; s < 4; ++s) sn += vs[s] * CO[(4 + s) * 128 + k];
        *(f32x4*)(Sout + (size_t)j * 128) = sn; }
#pragma unroll
    for (int t = 0; t < 4; ++t) *(LAS f32x4*)(PART + (kq * 4 + t) * 128 + 4 * v4) = op[t];
    __syncthreads();
    { const int t = tid >> 7, v = tid & 127; float o = 0.f;
#pragma unroll
      for (int g = 0; g < 16; ++g) o += PART[(g * 4 + t) * 128 + v];
      for (int s = 0; s <= t; ++s) { const int n = t * (t + 1) / 2 + s; o += (AP[n] + AP[16 + n]) * VV[s * 128 + v]; }
      const float ss = wave_sum(o * o); if (lane == 0) RED[F.wave] = ss;
      __syncthreads();
      const float tot = RED[2 * t] + RED[2 * t + 1]; const float r = 1.0f / sqrtf(tot * (1.f / 128.f) + EPS);
      bf16* hr = F.H + (row0 + t) * LDH;
      hr[HC_HA + h * 128 + v] = (bf16)f2bf(o * r * F.a_gnorm[v] * bf2f(hr[HC_ZA + h * 128 + v])); }
    __syncthreads();
}
}


namespace sg {
typedef short bf16x8 __attribute__((ext_vector_type(8)));
typedef float f32x4 __attribute__((ext_vector_type(4)));
typedef unsigned u32x2 __attribute__((ext_vector_type(2)));
__device__ __forceinline__ f32x4 kloop(const bf16* A, int lda, const bf16* Bt, f32x4 acc, int lane) {
    const int fr = lane & 15, fq = lane >> 4;
    const bf16* ap = A + (size_t)fr * lda + 8 * fq; const bf16* bp = Bt + (size_t)fr * D + 8 * fq;
#pragma unroll 8
    for (int ks = 0; ks < 32; ++ks) { const bf16x8 a = *(const bf16x8*)(ap + 32 * ks), b = *(const bf16x8*)(bp + 32 * ks); acc = __builtin_amdgcn_mfma_f32_16x16x32_bf16(b, a, acc, 0, 0, 0); }
    return acc;
}
__device__ __forceinline__ void merge_item(Frame& F, int item) {
    const int lane = F.lane, w = F.wave, rg = w & 3, cg = w >> 2, fr = lane & 15, fq = lane >> 4;
    const int rs = (item >> 5) * 64 + 16 * rg, col = (item & 31) * 32 + 16 * cg;
    const bf16* Hs = F.H + (size_t)(MP + rs) * LDH;
    f32x4 acc = {0.f, 0.f, 0.f, 0.f};
    acc = kloop(Hs + HC_HA, LDH, F.Wpa_t + (size_t)col * D, acc, lane);
    const bf16* gp = (const bf16*)(F.ws + WS_GABS) + (size_t)(rs + fr) * 2048 + col + 4 * fq;
    const u32x2 ga = *(const u32x2*)gp, gb = *(const u32x2*)(gp + 1024);
    const float b0 = pg8::bf_lo(gb.x), b1 = pg8::bf_hi(gb.x), b2 = pg8::bf_lo(gb.y), b3 = pg8::bf_hi(gb.y);
    acc[0] *= pg8::bf_lo(ga.x) * __builtin_amdgcn_rcpf(b0); acc[1] *= pg8::bf_hi(ga.x) * __builtin_amdgcn_rcpf(b1); acc[2] *= pg8::bf_lo(ga.y) * __builtin_amdgcn_rcpf(b2); acc[3] *= pg8::bf_hi(ga.y) * __builtin_amdgcn_rcpf(b3);
    acc = kloop(Hs + HC_HB, LDH, F.Wpb_t + (size_t)col * D, acc, lane);
    *(u32x2*)(F.H + (size_t)(MP + rs + fr) * LDH + HC_MG + col + 4 * fq) = (u32x2){pg8::cvt_pk_bf16(acc[0] * b0, acc[1] * b1), pg8::cvt_pk_bf16(acc[2] * b2, acc[3] * b3)};
}
__device__ __forceinline__ void out_item(Frame& F, int item) {
    const int lane = F.lane, w = F.wave, rg = w & 3, cg = w >> 2, fr = lane & 15, fq = lane >> 4;
    const int rs = (item >> 5) * 64 + 16 * rg, col = (item & 31) * 32 + 16 * cg;
    f32x4 acc = {0.f, 0.f, 0.f, 0.f};
    acc = kloop(F.H + (size_t)(MP + rs) * LDH + HC_MG, LDH, F.Wout_t + (size_t)col * D, acc, lane);
    const f32x4 y = *(const f32x4*)(F.xs + (size_t)(rs + fr) * D + col + 4 * fq) + acc;
    *(f32x4*)((float*)(F.H + (size_t)(MP + rs + fr) * LDH + HC_QB) + col + 4 * fq) = y;
    float ss = (y[0] * y[0] + y[1] * y[1]) + (y[2] * y[2] + y[3] * y[3]);
    ss += __shfl_xor(ss, 16); ss += __shfl_xor(ss, 32);
    if (fq == 0) ((float*)(F.ws + WS_SSQS))[(size_t)(rs + fr) * 64 + (item & 31) * 2 + cg] = ss;
}
}

__device__ __forceinline__ void p5_final_norm(Frame& F) {
    const int gw = F.vcu * NWAVES + F.wave, NGW = F.G * NWAVES;
    f32x4 gv[4];
#pragma unroll
    for (int j = 0; j < 4; ++j) gv[j] = ((const f32x4*)F.norm_final)[F.lane + 64 * j];
    for (int m = gw; m < M; m += NGW) {
        float s;
        if (m < MP) { s = F.lane < 16 ? F.SSQ[(size_t)m * 16 + F.lane] : 0.f; s += __shfl_xor(s, 1); s += __shfl_xor(s, 2); s += __shfl_xor(s, 4); s += __shfl_xor(s, 8); s = __shfl(s, 0); }
        else s = wave_sum(((const float*)(F.ws + WS_SSQS))[(size_t)(m - MP) * 64 + F.lane]);
        const float rstd = 1.0f / sqrtf(s * (1.f / D) + EPS);
        const f32x4* yt = (const f32x4*)(F.H + (size_t)m * LDH + HC_QB) + F.lane; f32x4* yr = (f32x4*)(F.out + O_Y + (size_t)m * D) + F.lane;
#pragma unroll
        for (int j = 0; j < 4; ++j) { f32x4 y = yt[64 * j]; y = y * rstd * gv[j]; yr[64 * j] = y; }
    }
    { const int gt = F.vcu * 512 + F.tid, NT = F.G * 512;
      for (int i = gt; i < 128 * 128 * 32; i += NT) { const int c4 = (i & 31) * 4, rl = i >> 5, db = rl >> 7, l = rl & 127; const size_t dof = (size_t)rl * 128 + c4;
          f32x4 k, v; if (l < 124) { const size_t so = (size_t)(rl + 4) * 128 + c4; k = *(const f32x4*)(F.ck_in + so); v = *(const f32x4*)(F.cv_in + so); }
          else { const size_t so = (size_t)(db * 4 + (l - 124)) * 128 + c4; k = *(const f32x4*)(F.CKSN + so); v = *(const f32x4*)(F.CVSN + so); }
          *(f32x4*)(F.out + O_CKS + dof) = k; *(f32x4*)(F.out + O_CVS + dof) = v; }
      for (int i = gt; i < 8 * 128 * 32; i += NT) { const size_t o = (size_t)i * 4; *(f32x4*)(F.out + O_CKP + o) = *(const f32x4*)(F.CKP + o); *(f32x4*)(F.out + O_CVP + o) = *(const f32x4*)(F.CVP + o); } }
}

struct Args { const float* in[14]; float* out; unsigned char* ws; int ph_lo, ph_hi, li, pad; };
__global__ void __launch_bounds__(NWAVES * 64, 2) fwd(Args args) {
    extern __shared__ __attribute__((aligned(16))) unsigned char lds[];
    Frame F;
    F.lds = (LAS unsigned char*)lds;
    F.tid = threadIdx.x; F.lane = F.tid & 63; F.wave = __builtin_amdgcn_readfirstlane(F.tid >> 6);
    F.G = gridDim.x; { const int bx = blockIdx.x; F.vcu = (F.G % 8 == 0) ? (bx % 8) * (F.G / 8) + bx / 8 : bx; }
    F.xp = args.in[0]; F.xs = args.in[1]; F.st_in = args.in[2]; F.ck_in = args.in[3]; F.cv_in = args.in[4]; F.norm_in = args.in[5]; F.w_in = args.in[6]; F.lb_logits = args.in[7];
    F.a_gnorm = args.in[8]; F.b_sinks = args.in[9]; F.w_pa = args.in[10]; F.w_pb = args.in[11]; F.w_out = args.in[12]; F.norm_final = args.in[13];
    F.out = args.out; F.ws = args.ws; unsigned char* ws = args.ws;
    F.Win_t = (bf16*)(ws + WS_WIN); F.Wpa_t = (bf16*)(ws + WS_WPA); F.Wpb_t = (bf16*)(ws + WS_WPB); F.Wout_t = (bf16*)(ws + WS_WOUT);
    F.XN = (bf16*)(ws + WS_XN); F.H = (bf16*)(ws + WS_H); F.LB = (float*)(ws + WS_LB); F.SSQ = (float*)(ws + WS_SSQ);
    F.CKP = (float*)(ws + WS_CKP); F.CVP = (float*)(ws + WS_CVP); F.CKSN = (float*)(ws + WS_CKSN); F.CVSN = (float*)(ws + WS_CVSN);
    volatile LAS unsigned* MISC = (volatile LAS unsigned*)(F.lds + MISC_OFF);
    for (int u = F.tid; u < (LDS_BYTES - LDSCTL_OFF) / 4; u += NWAVES * 64) ((LAS unsigned*)(F.lds + LDSCTL_OFF))[u] = 0u;
    __syncthreads();
    XcdBarrier bar; bar.bar = (unsigned*)(ws + WS_CTL) + CW_BAR; bar.x = 0; bar.st = nullptr;
    if (N_LAUNCHES == 1) bar = xcd_barrier_post((unsigned*)(ws + WS_CTL) + CW_BAR, MISC + 8);
    const int lo = args.ph_lo, hi = args.ph_hi;
#define IN(k) (lo <= (k) && (k) < hi)
#define SEAM(k) do { if (IN(k) && IN((k) + 1)) xcd_barrier(bar); } while (0)

    if (IN(0)) { p0_prologue(F); SEAM(0); }
    if (IN(1)) {
        pg8::Gemm g{F.XN, F.XN, F.Win_t, F.Win_t, D, D, D}; pg8::StaticOrder S; S.init(M, NMIX, F.G, (int)blockIdx.x, 0, 16);
        pg8::EpiIn E{F.H, F.LB, F.CKP, F.CVP, F.CKSN, F.CVSN, 0, (pg8::bf16_t*)(ws + WS_GABS)};
        pg8::gemm_phase<pg8::EpiIn, pg8::StaticOrder>(F.lds, g, S, E);
        SEAM(1);
    }
    if (IN(2)) {
        unsigned* qctr = (unsigned*)(ws + WS_CTL) + CW_QUEUE;
        for (;;) {
            if (F.tid == 0) MISC[0] = __hip_atomic_fetch_add(qctr, 1u, __ATOMIC_RELAXED, __HIP_MEMORY_SCOPE_AGENT);
            __syncthreads();
            int it = (int)MISC[0];
            __syncthreads();
            if (it >= 192 + 512 + 1024 + 256) break;
            if (it < 192) { hg::hgrn_item<false>(F, it / 24, (it / 3) & 7, it % 3); continue; } it -= 192;
            if (it < 512) { sw::swa_unit(F, it >> 6, (it >> 1) & 31, it & 1); continue; } it -= 512;
            if (it < 1024) { smp::hgrn_sample_item(F, it >> 3, it & 7); continue; } it -= 1024;
            smp::swa_sample_unit(F, it >> 1, it & 1);
        }
        SEAM(2); }
    if (IN(3)) {
        for (int it = blockIdx.x; it < 256; it += F.G) hg::hgrn_item<true>(F, it >> 5, (it >> 2) & 7, it & 3);
        SEAM(3); }
    if (IN(4)) {
        pg8::Gemm g{F.XN, F.XN, F.Win_t + (size_t)NMIX * D, F.Win_t + (size_t)NMIX * D, D, D, D}; pg8::StaticOrder S; S.init(MP, 2048, F.G, (int)blockIdx.x, 0);
        pg8::EpiIn E{F.H, F.LB, F.CKP, F.CVP, F.CKSN, F.CVSN, 1, (pg8::bf16_t*)(ws + WS_GABS)};
        pg8::gemm_phase<pg8::EpiIn, pg8::StaticOrder>(F.lds, g, S, E);
        SEAM(4);
    }
    if (IN(5)) {
        pg8::Gemm g{F.H + HC_HA, F.H + HC_HB, F.Wpa_t, F.Wpb_t, LDH, D, D}; pg8::StaticOrder S; S.init(MP, D, F.G, (int)blockIdx.x, 1);
        pg8::EpiMerge E{F.H, F.H + HC_MG};
        pg8::gemm_phase<pg8::EpiMerge, pg8::StaticOrder>(F.lds, g, S, E);
        for (int it = blockIdx.x; it < 256; it += F.G) sg::merge_item(F, it);
        SEAM(5);
    }
    if (IN(6)) {
        pg8::Gemm g{F.H + HC_MG, F.H + HC_MG, F.Wout_t, F.Wout_t, LDH, D, D}; pg8::StaticOrder S; S.init(MP, D, F.G, (int)blockIdx.x, 0);
        pg8::EpiOut E{F.xp, F.xs, F.H + HC_QB, F.SSQ};
        pg8::gemm_phase<pg8::EpiOut, pg8::StaticOrder>(F.lds, g, S, E);
        for (int it = blockIdx.x; it < 256; it += F.G) sg::out_item(F, it);
        SEAM(6);
    }
    if (IN(7)) { p5_final_norm(F); }
#undef IN
#undef SEAM
}

extern "C" void kernel_launch(void* const* d_in, const int* in_sizes, int n_in, void* d_out, int out_size, void* d_ws, size_t ws_size, hipStream_t stream) {
    static int grid = 0;
    if (grid == 0) {
        if (n_in != 14 || (size_t)out_size != O_END || ws_size < 512 * MiB) { fprintf(stderr, "kernel_launch: unexpected shapes: n_in %d out %d ws %zu (need %zu)\n", n_in, out_size, ws_size, (size_t)WS_END); grid = -1; return; }
        int dev = 0, cus = 0;
        if (hipGetDevice(&dev) != hipSuccess || hipDeviceGetAttribute(&cus, hipDeviceAttributeMultiprocessorCount, dev) != hipSuccess) { grid = -1; return; }
        if (hipFuncSetAttribute((const void*)fwd, hipFuncAttributeMaxDynamicSharedMemorySize, LDS_BYTES) != hipSuccess) { fprintf(stderr, "kernel_launch: hipFuncSetAttribute failed\n"); grid = -1; return; }
        int per_cu = 0;
        (void)hipOccupancyMaxActiveBlocksPerMultiprocessor(&per_cu, (const void*)fwd, NWAVES * 64, LDS_BYTES);
        (void)hipGetLastError();
        grid = cus;
    }
    if (grid < 0) return;
    (void)hipMemsetAsync((char*)d_ws + WS_CTL, 0, CTL_ZERO_BYTES, stream);
    Args a{};
    for (int i = 0; i < 14; ++i) a.in[i] = (const float*)d_in[i];
    a.out = (float*)d_out; a.ws = (unsigned char*)d_ws;
    for (int li = 0; li < N_LAUNCHES; ++li) {
        a.ph_lo = (N_LAUNCHES == 1) ? 0 : li; a.ph_hi = (N_LAUNCHES == 1) ? NPHASE : li + 1; a.li = li;
        hipLaunchKernelGGL(fwd, dim3(grid), dim3(NWAVES * 64), LDS_BYTES, stream, a);
    }
}
```
